# Optimizing an MI355X kernel written in HIP

```python
import jax, jax.numpy as jnp
from jax import lax
import numpy as np

D_MODEL = 1024
BATCH = 8
SEQ = 2048
DEPTH = 2
DEC_BATCH = 32
DEC_SEQ = 64
PAST_LEN = 1024

CHUNK = 64
N_LEFT_CHUNKS = 8
BAND_CHUNKS = N_LEFT_CHUNKS + 1
BAND_ROWS = N_LEFT_CHUNKS * CHUNK
N_A_LAYERS = DEPTH // 2
N_B_LAYERS = DEPTH - N_A_LAYERS
HEAD_DIM = 64
LRU_WIDTH = 3 * D_MODEL // 4
LRU_BLOCKS = LRU_WIDTH // HEAD_DIM
LRU_BLOCK = LRU_WIDTH // LRU_BLOCKS
CONV_WIDTH = 4
LRU_C = 8.0
ATT_WIDTH = 3 * D_MODEL // 4
N_ATT_HEADS = ATT_WIDTH // HEAD_DIM
N_MEM = 256
N_MEM_HEADS = 4
MEM_WIDTH = N_MEM_HEADS * HEAD_DIM
MIX_WIDTH = LRU_WIDTH + MEM_WIDTH
D_FF = -(-8 * D_MODEL // (3 * 256)) * 256
REL_CLIP = 256
RMS_EPS = 1e-6
NEG_INF = -1e30

kernel_name = 'yoco_rglru_chunkband_stream_step'


def rmsnorm(x, g):
    xf = x.astype(jnp.float32)
    y = xf * lax.rsqrt(jnp.mean(xf * xf, axis=-1, keepdims=True) + RMS_EPS)
    return (y * g.astype(jnp.float32)).astype(x.dtype)


def causal_conv(x, buf, w, b):
    T = x.shape[1]
    xp = jnp.concatenate([buf.astype(x.dtype), x], axis=1)
    y = b + xp[:, CONV_WIDTH - 1:CONV_WIDTH - 1 + T] * w[CONV_WIDTH - 1]
    for k in range(CONV_WIDTH - 1):
        y = y + xp[:, k:k + T] * w[k]
    return y, xp[:, T:]


def rglru(x, h0, w_a, b_a, w_i, b_i, lam, reset_first):
    B, T, _ = x.shape
    xb = x.reshape(B, T, LRU_BLOCKS, LRU_BLOCK)
    r = jax.nn.sigmoid(jnp.einsum('btni,nij->btnj', xb, w_a).reshape(B, T, LRU_WIDTH) + b_a)
    i = jax.nn.sigmoid(jnp.einsum('btni,nij->btnj', xb, w_i).reshape(B, T, LRU_WIDTH) + b_i)
    log_a = -LRU_C * r.astype(jnp.float32) * jax.nn.softplus(-lam.astype(jnp.float32))
    a = jnp.exp(log_a)
    mult = jnp.sqrt(-jnp.expm1(2.0 * log_a))
    if reset_first:
        mult = mult.at[:, 0].set(1.0)
    u = mult * (i * x).astype(jnp.float32)
    u = u.at[:, 0].add(a[:, 0] * h0.astype(jnp.float32))

    def combine(left, right):
        a_l, b_l = left
        a_r, b_r = right
        return a_l * a_r, a_r * b_l + b_r

    _, h = lax.associative_scan(combine, (a, u), axis=1)
    return h.astype(x.dtype), h[:, -1].astype(h0.dtype)


def rel_bias_lookup(rel, dist):
    idx = jnp.clip(dist, -REL_CLIP, REL_CLIP) + REL_CLIP
    return jnp.moveaxis(rel[idx], -1, 0).astype(jnp.float32)


def band_attend_prompt(q, k, v, rel):
    B, T, _ = q.shape
    NC = T // CHUNK
    BAND = BAND_CHUNKS * CHUNK
    qh = q.reshape(B, NC, CHUNK, N_ATT_HEADS, HEAD_DIM)
    pad = jnp.zeros((B, N_LEFT_CHUNKS * CHUNK, N_ATT_HEADS, HEAD_DIM), k.dtype)
    kc = jnp.concatenate([pad, k], axis=1).reshape(B, NC + N_LEFT_CHUNKS, CHUNK, N_ATT_HEADS, HEAD_DIM)
    vc = jnp.concatenate([pad.astype(v.dtype), v], axis=1).reshape(B, NC + N_LEFT_CHUNKS, CHUNK, N_ATT_HEADS, HEAD_DIM)
    kb = jnp.concatenate([kc[:, o:o + NC] for o in range(BAND_CHUNKS)], axis=2)
    vb = jnp.concatenate([vc[:, o:o + NC] for o in range(BAND_CHUNKS)], axis=2)
    s = jnp.einsum('bcqhd,bckhd->bhcqk', qh, kb).astype(jnp.float32) * (HEAD_DIM ** -0.5)
    qi = jnp.arange(CHUNK)[:, None]
    kj = jnp.arange(BAND)[None, :]
    bias = rel_bias_lookup(rel, N_LEFT_CHUNKS * CHUNK + qi - kj)
    kpos = (jnp.arange(NC)[:, None] - N_LEFT_CHUNKS) * CHUNK + jnp.arange(BAND)[None, :]
    s = s + bias[None, :, None]
    s = jnp.where((kpos >= 0)[None, None, :, None, :], s, NEG_INF)
    p = jax.nn.softmax(s, axis=-1).astype(v.dtype)
    o = jnp.einsum('bhcqk,bckhd->bcqhd', p, vb)
    return o.reshape(B, T, ATT_WIDTH)


def band_attend_sample(q, k_all, v_all, rel):
    B, T, _ = q.shape
    L = k_all.shape[1] - T
    qh = q.reshape(B, T, N_ATT_HEADS, HEAD_DIM)
    qpos = PAST_LEN + jnp.arange(T)
    kpos = PAST_LEN - L + jnp.arange(L + T)
    bias = rel_bias_lookup(rel, qpos[:, None] - kpos[None, :])
    s = jnp.einsum('bthd,bkhd->bhtk', qh, k_all).astype(jnp.float32) * (HEAD_DIM ** -0.5) + bias[None]
    p = jax.nn.softmax(s, axis=-1).astype(v_all.dtype)
    return jnp.einsum('bhtk,bkhd->bthd', p, v_all).reshape(B, T, ATT_WIDTH)


def mem_kv(mem, g, w):
    B = mem.shape[0]
    kv = rmsnorm(mem, g) @ w
    k = kv[..., :MEM_WIDTH].reshape(B, N_MEM, N_MEM_HEADS, HEAD_DIM)
    v = kv[..., MEM_WIDTH:].reshape(B, N_MEM, N_MEM_HEADS, HEAD_DIM)
    return k, v


def mem_attend(q, k, v):
    B, T, _ = q.shape
    qh = q.reshape(B, T, N_MEM_HEADS, HEAD_DIM)
    s = jnp.einsum('bthd,bmhd->bhtm', qh, k.astype(q.dtype)).astype(jnp.float32) * (HEAD_DIM ** -0.5)
    p = jax.nn.softmax(s, axis=-1).astype(q.dtype)
    return jnp.einsum('bhtm,bmhd->bthd', p, v.astype(q.dtype)).reshape(B, T, MEM_WIDTH)


def trunk(x, is_prompt, conv_buf, lru_h, past_k, past_v, mem_k, mem_v, p):
    new_conv, new_lru = [], []
    k_sh = None
    v_sh = None
    for l in range(DEPTH):
        h = rmsnorm(x, p['g_mix'][l])
        if l < N_A_LAYERS:
            proj = h @ p['w_in_a'][l]
            xr = proj[..., :LRU_WIDTH]
            gate = proj[..., LRU_WIDTH:2 * LRU_WIDTH]
            mq = proj[..., 2 * LRU_WIDTH:]
            xc, buf = causal_conv(xr, conv_buf[l], p['conv_w'][l], p['conv_b'][l])
            hs, h_last = rglru(xc, lru_h[l], p['w_rg_a'][l], p['b_rg_a'][l], p['w_rg_i'][l],
                               p['b_rg_i'][l], p['lru_lambda'][l], is_prompt)
            mix = hs * jax.nn.gelu(gate)
            new_conv.append(buf)
            new_lru.append(h_last)
        else:
            lb = l - N_A_LAYERS
            proj = h @ p['w_in_b'][lb]
            q = proj[..., :ATT_WIDTH]
            mq = proj[..., ATT_WIDTH:]
            if is_prompt:
                mix = band_attend_prompt(q, k_sh, v_sh, p['rel_bias'][lb])
            else:
                k_all = jnp.concatenate([past_k.astype(k_sh.dtype), k_sh], axis=1)
                v_all = jnp.concatenate([past_v.astype(v_sh.dtype), v_sh], axis=1)
                mix = band_attend_sample(q, k_all, v_all, p['rel_bias'][lb])
        mo = mem_attend(mq, mem_k[l], mem_v[l])
        x = x + jnp.concatenate([mix, mo], axis=-1) @ p['w_out'][l]
        hf = rmsnorm(x, p['g_ffn'][l])
        gu = hf @ p['w_ffn_gu'][l]
        x = x + (jax.nn.silu(gu[..., :D_FF]) * gu[..., D_FF:]) @ p['w_ffn_down'][l]
        if l == N_A_LAYERS - 1:
            B, T, _ = x.shape
            kv = rmsnorm(x, p['g_kv']) @ p['w_kv']
            k_sh = kv[..., :ATT_WIDTH].reshape(B, T, N_ATT_HEADS, HEAD_DIM)
            v_sh = kv[..., ATT_WIDTH:].reshape(B, T, N_ATT_HEADS, HEAD_DIM)
    y = rmsnorm(x, p['g_final'])
    return y, jnp.stack(new_conv), jnp.stack(new_lru), k_sh, v_sh


def setup_inputs(seed: int = 0) -> dict:
    key = jax.random.key(seed)
    ks = jax.random.split(key, 32)
    f32 = jnp.float32

    def nrm(k, shape, scale):
        return jax.random.normal(k, shape, f32) * scale

    band_len = min(BAND_ROWS, PAST_LEN)
    a0 = jax.random.uniform(ks[14], (N_A_LAYERS, LRU_WIDTH), f32, 0.9, 0.999)
    a = a0 ** (1.0 / LRU_C)
    lam = jnp.log(a) - jnp.log1p(-a)
    return {
        'x_prompt': nrm(ks[0], (BATCH, SEQ, D_MODEL), 1.0),
        'x_sample': nrm(ks[1], (DEC_BATCH, DEC_SEQ, D_MODEL), 1.0),
        'state_conv': nrm(ks[2], (N_A_LAYERS, DEC_BATCH, CONV_WIDTH - 1, LRU_WIDTH), 1.0),
        'state_lru': nrm(ks[3], (N_A_LAYERS, DEC_BATCH, LRU_WIDTH), 0.5),
        'cache_k': nrm(ks[4], (DEC_BATCH, band_len, N_ATT_HEADS, HEAD_DIM), 1.0),
        'cache_v': nrm(ks[5], (DEC_BATCH, band_len, N_ATT_HEADS, HEAD_DIM), 1.0),
        'cache_mem_k': nrm(ks[6], (DEPTH, DEC_BATCH, N_MEM, N_MEM_HEADS, HEAD_DIM), 1.0),
        'cache_mem_v': nrm(ks[7], (DEPTH, DEC_BATCH, N_MEM, N_MEM_HEADS, HEAD_DIM), 1.0),
        'mem_prompt': nrm(ks[8], (BATCH, N_MEM, D_MODEL), 1.0),
        'g_mix': 1.0 + nrm(ks[9], (DEPTH, D_MODEL), 0.05),
        'g_ffn': 1.0 + nrm(ks[10], (DEPTH, D_MODEL), 0.05),
        'g_final': 1.0 + nrm(ks[11], (D_MODEL,), 0.05),
        'w_in_a': nrm(ks[12], (N_A_LAYERS, D_MODEL, 2 * LRU_WIDTH + MEM_WIDTH), D_MODEL ** -0.5),
        'conv_w': nrm(ks[13], (N_A_LAYERS, CONV_WIDTH, LRU_WIDTH), CONV_WIDTH ** -0.5),
        'conv_b': nrm(ks[15], (N_A_LAYERS, LRU_WIDTH), 0.02),
        'w_rg_a': nrm(ks[16], (N_A_LAYERS, LRU_BLOCKS, LRU_BLOCK, LRU_BLOCK), LRU_BLOCK ** -0.5),
        'b_rg_a': nrm(ks[17], (N_A_LAYERS, LRU_WIDTH), 0.02),
        'w_rg_i': nrm(ks[18], (N_A_LAYERS, LRU_BLOCKS, LRU_BLOCK, LRU_BLOCK), LRU_BLOCK ** -0.5),
        'b_rg_i': nrm(ks[19], (N_A_LAYERS, LRU_WIDTH), 0.02),
        'lru_lambda': lam,
        'g_kv': 1.0 + nrm(ks[20], (D_MODEL,), 0.05),
        'w_kv': nrm(ks[21], (D_MODEL, 2 * ATT_WIDTH), D_MODEL ** -0.5),
        'w_in_b': nrm(ks[22], (N_B_LAYERS, D_MODEL, ATT_WIDTH + MEM_WIDTH), D_MODEL ** -0.5),
        'rel_bias': nrm(ks[23], (N_B_LAYERS, 2 * REL_CLIP + 1, N_ATT_HEADS), 0.5),
        'g_mem': 1.0 + nrm(ks[24], (DEPTH, D_MODEL), 0.05),
        'w_mem_kv': nrm(ks[25], (DEPTH, D_MODEL, 2 * MEM_WIDTH), D_MODEL ** -0.5),
        'w_out': nrm(ks[26], (DEPTH, MIX_WIDTH, D_MODEL), MIX_WIDTH ** -0.5),
        'w_ffn_gu': nrm(ks[27], (DEPTH, D_MODEL, 2 * D_FF), D_MODEL ** -0.5),
        'w_ffn_down': nrm(ks[28], (DEPTH, D_FF, D_MODEL), D_FF ** -0.5),
    }


def reference(x_prompt, x_sample, state_conv, state_lru, cache_k, cache_v, cache_mem_k, cache_mem_v,
              mem_prompt, g_mix, g_ffn, g_final, w_in_a, conv_w, conv_b, w_rg_a, b_rg_a, w_rg_i, b_rg_i,
              lru_lambda, g_kv, w_kv, w_in_b, rel_bias, g_mem, w_mem_kv, w_out, w_ffn_gu, w_ffn_down):
    p = {'g_mix': g_mix, 'g_ffn': g_ffn, 'g_final': g_final, 'w_in_a': w_in_a, 'conv_w': conv_w,
         'conv_b': conv_b, 'w_rg_a': w_rg_a, 'b_rg_a': b_rg_a, 'w_rg_i': w_rg_i, 'b_rg_i': b_rg_i,
         'lru_lambda': lru_lambda, 'g_kv': g_kv, 'w_kv': w_kv, 'w_in_b': w_in_b, 'rel_bias': rel_bias,
         'w_out': w_out, 'w_ffn_gu': w_ffn_gu, 'w_ffn_down': w_ffn_down}
    mk_list, mv_list = [], []
    for l in range(DEPTH):
        mk, mv = mem_kv(mem_prompt, g_mem[l], w_mem_kv[l])
        mk_list.append(mk)
        mv_list.append(mv)
    mem_k_p = jnp.stack(mk_list)
    mem_v_p = jnp.stack(mv_list)
    B = x_prompt.shape[0]
    conv0 = jnp.zeros((N_A_LAYERS, B, CONV_WIDTH - 1, LRU_WIDTH), x_prompt.dtype)
    lru0 = jnp.zeros((N_A_LAYERS, B, LRU_WIDTH), state_lru.dtype)
    y_prompt, conv_p, lru_p, k_p, v_p = trunk(x_prompt, True, conv0, lru0, None, None, mem_k_p, mem_v_p, p)
    y_sample, conv_s, lru_s, k_s, v_s = trunk(x_sample, False, state_conv, state_lru, cache_k, cache_v,
                                              cache_mem_k, cache_mem_v, p)
    nb = min(BAND_ROWS, x_prompt.shape[1])
    return (y_prompt, y_sample, conv_p, lru_p, k_p[:, -nb:], v_p[:, -nb:], mem_k_p, mem_v_p,
            conv_s, lru_s, k_s, v_s)
```

```cpp
#include <hip/hip_runtime.h>
#include <hip/hip_cooperative_groups.h>
#include <cstdio>
#include <cstdint>
namespace cg = cooperative_groups;
namespace pg8 {
#define PG8_LAS __attribute__((address_space(3)))
typedef unsigned short bf16_t;
typedef short bf16x8 __attribute__((ext_vector_type(8)));
typedef float f32x4 __attribute__((ext_vector_type(4)));
typedef unsigned u32x4 __attribute__((ext_vector_type(4)));
constexpr int BM = 256, BK = 64, HALF = 128, HTB = HALF * BK * 2  , STAGE_BYTES = 8 * HTB, NXCD = 8, WGM = 8;

__host__ __device__ __forceinline__ int lds_byte(int r, int c) { const int st = (r >> 4) * 2 + (c >> 5), rr = r & 15, cc = c & 31, ob = rr * 64 + cc * 2; return st * 1024 + (ob ^ (((ob >> 9) & 1) << 5)); }
__host__ __device__ __forceinline__ void stage_rc(int b, int& R, int& C) { const int st = b / 1024, sb = b % 1024, swz = sb ^ (((sb >> 9) & 1) << 5); R = (st >> 1) * 16 + swz / 64; C = (st & 1) * 32 + (swz % 64) / 2; }
__host__ __device__ __forceinline__ int perm32(int rho) { const int n = rho >> 4, i = rho & 15; return 8 * (i >> 2) + 4 * n + (i & 3); }

struct Unit { int pm, pn, k0, nt, sp; };
struct Gemm { const bf16_t* A; const bf16_t* Bt; int M, N, K; };

struct StaticOrder {
    int nM, nN, nwg, G, c, ntf; const float* ssrc = nullptr; mutable float pre[8];
    __host__ __device__ __forceinline__ void init(int M, int N, int K, int G_, int c_) { nM = M / BM; nN = N / BM; nwg = nM * nN; G = G_; c = c_; ntf = K / BK; }
    __host__ __device__ __forceinline__ bool next(int i, Unit& u) const {
        const long L = (long)i * G + c; if (L >= nwg) return false;
        int wgid = (int)L; { const int q = nwg / NXCD, r = nwg % NXCD, xcd = wgid % NXCD, off = wgid / NXCD; wgid = (xcd < r ? xcd * (q + 1) : r * (q + 1) + (xcd - r) * q) + off; }
        const int nig = WGM * nN, gid = wgid / nig, fm = gid * WGM, gsz = (nM - fm) < WGM ? (nM - fm) : WGM;
        u.pm = fm + ((wgid % nig) % gsz); u.pn = (wgid % nig) / gsz; u.k0 = 0; u.nt = ntf; u.sp = 0; return true;
    }
    __host__ __device__ __forceinline__ Unit get(int i) const {
        const long L = (long)i * G + c; const bool ok = L < nwg;
        int wgid = ok ? (int)L : 0; { const int q = nwg / NXCD, r = nwg % NXCD, xcd = wgid % NXCD, off = wgid / NXCD; wgid = (xcd < r ? xcd * (q + 1) : r * (q + 1) + (xcd - r) * q) + off; }
        const int nig = WGM * nN, gid = wgid / nig, fm = gid * WGM, gsz = (nM - fm) < WGM ? (nM - fm) : WGM;
        Unit u; u.pm = ok ? fm + ((wgid % nig) % gsz) : -1; u.pn = (wgid % nig) / gsz; u.k0 = 0; u.nt = ntf; u.sp = 0; return u;
    }
    __device__ __forceinline__ void prefetch(const Unit& u, int wr, int fr) const {
        if (ssrc) { _Pragma("unroll") for (int ai = 0; ai < 2; ++ai) _Pragma("unroll") for (int m = 0; m < 4; ++m) pre[ai * 4 + m] = ssrc[u.pm * BM + ai * HALF + wr * 64 + m * 16 + fr]; } }
    __device__ __forceinline__ void a_ready(const Unit&) const {}
    __device__ __forceinline__ void done(const Unit&) const {}
};

struct ResidOrder {
    StaticOrder S0; int G, c, ntf;
    __host__ __device__ __forceinline__ void init(int K, int G_, int c_) { S0.init(16384, 1024, K, G_, c_); G = G_; c = c_; ntf = K / BK; }
    __host__ __device__ __forceinline__ bool next(int i, Unit& u) const {
        const long L = (long)i * G + c; if (L < 256) return S0.next(i, u);
        const int L2 = (int)(L - 256); if (L2 >= 256) return false;
        const int su = L2 >> 3, sp = L2 & 7, base = (ntf / 8) & ~1, rem2 = (ntf - 8 * base) / 2;
        u.pm = 64 + (su >> 2); u.pn = su & 3; u.sp = sp; u.nt = base + (sp < rem2 ? 2 : 0); u.k0 = sp * base + 2 * (sp < rem2 ? sp : rem2); return true;
    }
    __host__ __device__ __forceinline__ Unit get(int i) const {
        const long L = (long)i * G + c; const Unit u0 = S0.get(i);
        const int L2 = (int)(L - 256); const bool tail = L >= 256, ok = L2 < 256;
        const int su = (L2 >> 3) & 31, sp = L2 & 7, base = (ntf / 8) & ~1, rem2 = (ntf - 8 * base) / 2;
        Unit u; u.pm = tail ? (ok ? 64 + (su >> 2) : -1) : u0.pm; u.pn = tail ? (su & 3) : u0.pn; u.sp = tail ? sp : 0;
        u.nt = tail ? base + (sp < rem2 ? 2 : 0) : ntf; u.k0 = tail ? sp * base + 2 * (sp < rem2 ? sp : rem2) : 0; return u;
    }
    __device__ __forceinline__ void prefetch(const Unit&, int, int) const {}
    __device__ __forceinline__ void a_ready(const Unit&) const {}
    __device__ __forceinline__ void done(const Unit&) const {}
};

typedef float f32x2c_t __attribute__((ext_vector_type(2))); typedef __bf16 bf16x2c_t __attribute__((ext_vector_type(2)));
__device__ __forceinline__ unsigned cvt_pk_bf16(float lo, float hi) { f32x2c_t v = {lo, hi}; bf16x2c_t b = __builtin_convertvector(v, bf16x2c_t); return __builtin_bit_cast(unsigned, b); }
typedef float f32x2 __attribute__((ext_vector_type(2)));
template <class Epi, class Sched, bool ALIGN_EPI = false, bool SP2 = false>
__device__ __forceinline__ void gemm_phase(PG8_LAS unsigned char* lds, const Gemm g, const Sched& S, const Epi& E) {
    const int tid = threadIdx.x, wid = __builtin_amdgcn_readfirstlane(tid >> 6), lane = tid & 63, wr = wid >> 2, wc = wid & 3, fr = lane & 15, fq = lane >> 4;
    const int K = g.K;
    unsigned voffA[2], voffB[2];
#pragma unroll
    for (int i = 0; i < 2; ++i) { int R, C; stage_rc(tid * 16 + i * 8192, R, C); const int Rb = Epi::PERM ? ((R & ~31) + perm32(R & 31)) : R;
        voffA[i] = (unsigned)(R * K + C) * 2u; voffB[i] = (unsigned)(Rb * K + C) * 2u; }
    const size_t kstep = (size_t)(BK * 2);
    const size_t hstep = (size_t)HALF * K * 2;
    const size_t tstep = 2 * hstep;
    const unsigned ldsw = (unsigned)wid * 1024u;
    const int aoff = lds_byte(wr * 64 + fr, fq * 8), boff = lds_byte(wc * 32 + fr, fq * 8);
#define PG8_SA(b, h) (((b) * 2 + (h)) * HTB)
#define PG8_SB(b, h) ((4 + (b) * 2 + (h)) * HTB)
#define PG8_STAGE(bufoff, gbase, voff) do { _Pragma("unroll") for (int _i = 0; _i < 2; ++_i) \
        __builtin_amdgcn_global_load_lds((const unsigned*)((const char*)(gbase) + (voff)[_i]), (PG8_LAS unsigned*)(lds + (bufoff) + ldsw + _i * 8192), 16, 0, 0); } while (0)
#define PG8_LDA(dst, b, h) do { _Pragma("unroll") for (int m = 0; m < 4; ++m) _Pragma("unroll") for (int k = 0; k < 2; ++k) dst[m][k] = *(const PG8_LAS bf16x8*)(lds + PG8_SA(b, h) + aoff + m * 2048 + k * 1024); } while (0)
#define PG8_LDB(dst, b, h) do { _Pragma("unroll") for (int n = 0; n < 2; ++n) _Pragma("unroll") for (int k = 0; k < 2; ++k) dst[n][k] = *(const PG8_LAS bf16x8*)(lds + PG8_SB(b, h) + boff + n * 2048 + k * 1024); } while (0)
#define PG8_MMA(ai, bj, At, Bt) do { __builtin_amdgcn_s_setprio(1); _Pragma("unroll") for (int m = 0; m < 4; ++m) _Pragma("unroll") for (int n = 0; n < 2; ++n) _Pragma("unroll") for (int k = 0; k < 2; ++k) \
        acc[ai][bj][m][n] = __builtin_amdgcn_mfma_f32_16x16x32_bf16(Bt[n][k], At[m][k], acc[ai][bj][m][n], 0, 0, 0); __builtin_amdgcn_s_setprio(0); } while (0)
#define PG8_WAIT_V(n) asm volatile("s_waitcnt vmcnt(" #n ")" ::: "memory")
#define PG8_WAIT_L(n) asm volatile("s_waitcnt lgkmcnt(" #n ")" ::: "memory")
#define PG8_BAR __builtin_amdgcn_s_barrier()
#define PG8_SCHED __builtin_amdgcn_sched_barrier(0)
    Unit cur, nxt; int ui = 0;
    cur = S.get(0); if (cur.pm < 0) return;
    f32x4 acc[2][2][4][2];
#pragma unroll
    for (int a = 0; a < 2; ++a)
#pragma unroll
        for (int b = 0; b < 2; ++b)
#pragma unroll
            for (int m = 0; m < 4; ++m)
#pragma unroll
                for (int n = 0; n < 2; ++n) acc[a][b][m][n] = (f32x4){0.f, 0.f, 0.f, 0.f};
    bf16x8 At[4][2], B0[2][2], B1[2][2];
    const char* cA = (const char*)g.A + (size_t)cur.pm * tstep + (size_t)cur.k0 * kstep; const char* cB = (const char*)g.Bt + (size_t)cur.pn * tstep + (size_t)cur.k0 * kstep;
    int nt = cur.nt;
    S.a_ready(cur); S.prefetch(cur, wr, fr);
    if constexpr (SP2) {
        PG8_STAGE(PG8_SB(0, 0), cB, voffB); PG8_STAGE(PG8_SB(0, 1), cB + hstep, voffB); PG8_STAGE(PG8_SA(0, 0), cA, voffA); PG8_STAGE(PG8_SA(0, 1), cA + hstep, voffA);
        if (wr == 1) PG8_BAR;
        PG8_WAIT_V(2); PG8_BAR;
        PG8_STAGE(PG8_SB(1, 0), cB + kstep, voffB); PG8_STAGE(PG8_SA(1, 0), cA + kstep, voffA); PG8_STAGE(PG8_SB(1, 1), cB + hstep + kstep, voffB);
        PG8_WAIT_V(6); PG8_BAR;
    } else {
        PG8_STAGE(PG8_SB(0, 0), cB, voffB); PG8_STAGE(PG8_SA(0, 0), cA, voffA); PG8_STAGE(PG8_SB(0, 1), cB + hstep, voffB); PG8_STAGE(PG8_SA(0, 1), cA + hstep, voffA);
        if (wr == 1) PG8_BAR;
        PG8_WAIT_V(4); PG8_BAR;
        PG8_STAGE(PG8_SB(1, 0), cB + kstep, voffB); PG8_STAGE(PG8_SA(1, 0), cA + kstep, voffA); PG8_STAGE(PG8_SB(1, 1), cB + hstep + kstep, voffB);
        PG8_WAIT_V(6); PG8_BAR;
    }
    for (;;) {
        nxt = S.get(ui + 1); const bool has_next = nxt.pm >= 0;
        const char* nA = has_next ? (const char*)g.A + (size_t)nxt.pm * tstep + (size_t)nxt.k0 * kstep : cA; const char* nB = has_next ? (const char*)g.Bt + (size_t)nxt.pn * tstep + (size_t)nxt.k0 * kstep : cB;
        for (int t = 0; t < nt; t += 2) {
            const bool last = (t == nt - 2);
            const char* a1 = cA + (size_t)(t + 1) * kstep;
            const char* a2 = last ? nA : cA + (size_t)(t + 2) * kstep; const char* b2 = last ? nB : cB + (size_t)(t + 2) * kstep;
            const char* a3 = a2 + kstep; const char* b3 = b2 + kstep;
            if (last && has_next) S.a_ready(nxt);
            if constexpr (SP2) {
            PG8_LDB(B0, 0, 0); PG8_LDB(B1, 0, 1); PG8_SCHED; PG8_LDA(At, 0, 0); PG8_STAGE(PG8_SA(1, 1), a1 + hstep, voffA);
            PG8_WAIT_V(8); PG8_WAIT_L(0); PG8_BAR; PG8_MMA(0, 0, At, B0); PG8_MMA(0, 1, At, B1); PG8_BAR; PG8_SCHED;
            PG8_LDA(At, 0, 1); PG8_STAGE(PG8_SB(0, 0), b2, voffB); PG8_STAGE(PG8_SB(0, 1), b2 + hstep, voffB); PG8_STAGE(PG8_SA(0, 0), a2, voffA);
            PG8_WAIT_V(8); PG8_WAIT_L(0); PG8_BAR; PG8_MMA(1, 0, At, B0); PG8_MMA(1, 1, At, B1); PG8_BAR; PG8_SCHED;
            PG8_LDB(B0, 1, 0); PG8_LDB(B1, 1, 1); PG8_SCHED; PG8_LDA(At, 1, 0); PG8_STAGE(PG8_SA(0, 1), a2 + hstep, voffA);
            PG8_WAIT_V(8); PG8_WAIT_L(0); PG8_BAR; PG8_MMA(0, 0, At, B0); PG8_MMA(0, 1, At, B1); PG8_BAR; PG8_SCHED;
            PG8_LDA(At, 1, 1); PG8_STAGE(PG8_SB(1, 0), b3, voffB); PG8_STAGE(PG8_SB(1, 1), b3 + hstep, voffB); PG8_STAGE(PG8_SA(1, 0), a3, voffA);
            PG8_WAIT_V(8); PG8_WAIT_L(0); PG8_BAR; PG8_MMA(1, 0, At, B0); PG8_MMA(1, 1, At, B1); PG8_BAR; PG8_SCHED;
            } else {
            PG8_LDB(B0, 0, 0); PG8_SCHED; PG8_LDA(At, 0, 0); PG8_STAGE(PG8_SA(1, 1), a1 + hstep, voffA);
            PG8_WAIT_L(8); PG8_BAR; PG8_WAIT_L(0); PG8_MMA(0, 0, At, B0); PG8_BAR; PG8_SCHED;
            PG8_LDB(B1, 0, 1); PG8_STAGE(PG8_SB(0, 0), b2, voffB);
            PG8_BAR; PG8_WAIT_L(0); PG8_MMA(0, 1, At, B1); PG8_BAR;
            PG8_LDA(At, 0, 1); PG8_STAGE(PG8_SA(0, 0), a2, voffA);
            PG8_BAR; PG8_WAIT_L(0); PG8_MMA(1, 0, At, B0); PG8_BAR; PG8_SCHED;
            PG8_STAGE(PG8_SB(0, 1), b2 + hstep, voffB);
            PG8_WAIT_V(6); PG8_BAR; PG8_MMA(1, 1, At, B1); PG8_BAR;
            PG8_LDB(B0, 1, 0); PG8_SCHED; PG8_LDA(At, 1, 0); PG8_STAGE(PG8_SA(0, 1), a2 + hstep, voffA);
            PG8_WAIT_L(8); PG8_BAR; PG8_WAIT_L(0); PG8_MMA(0, 0, At, B0); PG8_BAR; PG8_SCHED;
            PG8_LDB(B1, 1, 1); PG8_STAGE(PG8_SB(1, 0), b3, voffB);
            PG8_BAR; PG8_WAIT_L(0); PG8_MMA(0, 1, At, B1); PG8_BAR;
            PG8_LDA(At, 1, 1); PG8_STAGE(PG8_SA(1, 0), a3, voffA);
            PG8_BAR; PG8_WAIT_L(0); PG8_MMA(1, 0, At, B0); PG8_BAR; PG8_SCHED;
            PG8_STAGE(PG8_SB(1, 1), b3 + hstep, voffB);
            PG8_WAIT_V(6); PG8_BAR; PG8_MMA(1, 1, At, B1); PG8_BAR;
            }
        }
        if constexpr (ALIGN_EPI) { if (wr == 0) PG8_BAR; }
        if constexpr (!Epi::AFTER_DRAIN) { E(acc, cur, wr, wc, fr, fq); S.done(cur); }
        if (!has_next) break;
#pragma unroll
        for (int a = 0; a < 2; ++a)
#pragma unroll
            for (int b = 0; b < 2; ++b)
#pragma unroll
                for (int m = 0; m < 4; ++m)
#pragma unroll
                    for (int n = 0; n < 2; ++n) acc[a][b][m][n] = (f32x4){0.f, 0.f, 0.f, 0.f};
        cur = nxt; cA = nA; cB = nB; nt = cur.nt; ++ui; S.prefetch(cur, wr, fr);
        if constexpr (ALIGN_EPI) { if (wr == 1) PG8_BAR; }
    }
    PG8_WAIT_V(0);
    if constexpr (!ALIGN_EPI) { if (wr == 0) PG8_BAR; }
    PG8_BAR;
    if constexpr (Epi::AFTER_DRAIN) { E.fused(acc, cur, wr, wc, fr, fq, lds, wid, lane); S.done(cur); }
#undef PG8_SA
#undef PG8_SB
#undef PG8_STAGE
#undef PG8_LDA
#undef PG8_LDB
#undef PG8_MMA
#undef PG8_WAIT_V
#undef PG8_WAIT_L
#undef PG8_BAR
#undef PG8_SCHED
}
}

#ifndef MK_N_LAUNCHES
#define MK_N_LAUNCHES 1
#endif
#ifndef DUP_MASK
#define DUP_MASK 0
#endif
using pg8::bf16_t; using pg8::bf16x8; using pg8::f32x4; using pg8::u32x4; using pg8::cvt_pk_bf16;
#define LAS __attribute__((address_space(3)))
typedef float f32x16 __attribute__((ext_vector_type(16)));
typedef float f32x2v __attribute__((ext_vector_type(2)));
typedef unsigned u32x2 __attribute__((ext_vector_type(2)));
typedef short s16x4 __attribute__((ext_vector_type(4)));

constexpr int DM = 1024, NP = 16384  , NS = 2048  , MT = NP + NS  ;
constexpr int TP = 2048, TS = 64, BP = 8, BS = 32;
constexpr int LW = 768, AW = 768, MW = 256, DFF = 2816;
constexpr int NINA = 2 * LW + MW;
constexpr int NKVQ = 2 * AW + AW + MW;
constexpr int NMEMR = BP * 256;
constexpr float RMS_EPS = 1e-6f;
constexpr float LOG2E = 1.4426950408889634f;

constexpr size_t O_Y = 0;
constexpr size_t O_CONVP = (size_t)MT * DM;
constexpr size_t O_LRUP = O_CONVP + (size_t)BP * 3 * LW;
constexpr size_t O_CKP = O_LRUP + (size_t)BP * LW;
constexpr size_t O_CVP = O_CKP + (size_t)BP * 512 * AW;
constexpr size_t O_MKP = O_CVP + (size_t)BP * 512 * AW;
constexpr size_t O_MVP = O_MKP + (size_t)2 * BP * 256 * MW;
constexpr size_t O_CONVS = O_MVP + (size_t)2 * BP * 256 * MW;
constexpr size_t O_LRUS = O_CONVS + (size_t)BS * 3 * LW;
constexpr size_t O_KS = O_LRUS + (size_t)BS * LW;
constexpr size_t O_VS = O_KS + (size_t)BS * TS * AW;
constexpr size_t O_END = O_VS + (size_t)BS * TS * AW;

constexpr size_t MiB = 1u << 20;
constexpr size_t WS_WINA = 0, WS_WKVB = 4 * MiB, WS_WMEM = 9 * MiB, WS_WOUT = 11 * MiB, WS_WGU = 15 * MiB, WS_WDN = 37 * MiB;
constexpr size_t WS_WG = 48 * MiB, WS_CAR = 49 * MiB, WS_MN = 51 * MiB, WS_MKV = 55 * MiB, WS_XN = 59 * MiB, WS_KV = 95 * MiB;
constexpr size_t WS_H = 149 * MiB, WS_PROJ = WS_H, WS_MIX = 212 * MiB, WS_PART = 248 * MiB, WS_END = 280 * MiB;
constexpr size_t WS_SS = WS_CAR + 3 * MiB / 2;
constexpr size_t WS_BAR = 51 * MiB - 128 * 1024;
constexpr int NSPLIT = 8;
static_assert(WS_PROJ + (size_t)MT * NINA * 2 <= WS_MIX && WS_MIX + (size_t)MT * DM * 2 <= WS_END && WS_H + (size_t)MT * DFF * 2 <= WS_END, "ws map");

constexpr int LDS_BYTES = 131072 + 1024;

__device__ __forceinline__ unsigned f2bf(float f) { unsigned u = __builtin_bit_cast(unsigned, f); return (u + 0x7fffu + ((u >> 16) & 1u)) >> 16; }
__device__ __forceinline__ float bf2f(bf16_t b) { return __builtin_bit_cast(float, (unsigned)b << 16); }
__device__ __forceinline__ float wave_sum(float v) {
#pragma unroll
    for (int o = 1; o < 64; o <<= 1) v += __shfl_xor(v, o);
    return v;
}
#define LDS_WAIT() asm volatile("s_waitcnt lgkmcnt(0)" ::: "memory")

typedef const f32x4 (&AccRef)[2][2][4][2];
__device__ __forceinline__ u32x4 pack8(f32x4 v0, f32x4 v1) { u32x4 w; w.x = cvt_pk_bf16(v0[0], v0[1]); w.y = cvt_pk_bf16(v0[2], v0[3]); w.z = cvt_pk_bf16(v1[0], v1[1]); w.w = cvt_pk_bf16(v1[2], v1[3]); return w; }

__device__ __forceinline__ float rstd_of(float ss) { return 1.0f / sqrtf(ss * (1.0f / DM) + RMS_EPS); }
struct EpiBf16Plain {
    static constexpr bool PERM = true, AFTER_DRAIN = false;
    bf16_t* O; int ldc; const float* pre;
    __device__ __forceinline__ void operator()(AccRef acc, const pg8::Unit& u, int wr, int wc, int fr, int fq) const {
        const int row0 = u.pm * 256 + wr * 64 + fr, col0 = u.pn * 256 + wc * 32 + 8 * fq;
#pragma unroll
        for (int ai = 0; ai < 2; ++ai)
#pragma unroll
            for (int m = 0; m < 4; ++m) { const int r = row0 + ai * 128 + m * 16; bf16_t* rowp = O + (size_t)r * ldc + col0; const float rs = rstd_of(pre[ai * 4 + m]);
#pragma unroll
                for (int bj = 0; bj < 2; ++bj) *(u32x4*)(rowp + bj * 128) = pack8(acc[ai][bj][m][0] * rs, acc[ai][bj][m][1] * rs); }
    }
};
struct EpiMemKV {
    static constexpr bool PERM = true, AFTER_DRAIN = false;
    bf16_t* O; float* out;
    __device__ __forceinline__ void operator()(AccRef acc, const pg8::Unit& u, int wr, int wc, int fr, int fq) const {
        const int row0 = u.pm * 256 + wr * 64 + fr, col0 = u.pn * 256 + wc * 32 + 8 * fq;
        const int l = u.pn >> 1, isv = u.pn & 1;
        float* fo = out + (isv ? O_MVP : O_MKP) + (size_t)l * (BP * 256 * MW) + wc * 32 + 8 * fq;
#pragma unroll
        for (int ai = 0; ai < 2; ++ai)
#pragma unroll
            for (int m = 0; m < 4; ++m) { const int r = row0 + ai * 128 + m * 16; bf16_t* rowp = O + (size_t)r * 1024 + col0; float* fr_ = fo + (size_t)r * MW;
#pragma unroll
                for (int bj = 0; bj < 2; ++bj) { *(u32x4*)(rowp + bj * 128) = pack8(acc[ai][bj][m][0], acc[ai][bj][m][1]);
                    *(f32x4*)(fr_ + bj * 128) = acc[ai][bj][m][0]; *(f32x4*)(fr_ + bj * 128 + 4) = acc[ai][bj][m][1]; } }
    }
};
struct EpiKVQ {
    static constexpr bool PERM = true, AFTER_DRAIN = false;
    bf16_t* KV; bf16_t* QB; float* out; const float* pre;
    __device__ __forceinline__ void operator()(AccRef acc, const pg8::Unit& u, int wr, int wc, int fr, int fq) const {
        const int rl0 = wr * 64 + fr, cl0 = wc * 32 + 8 * fq;
        if (u.pn >= 6) {
            bf16_t* base = QB + (size_t)(u.pm * 256 + rl0) * 1024 + (u.pn - 6) * 256 + cl0;
#pragma unroll
            for (int ai = 0; ai < 2; ++ai)
#pragma unroll
                for (int m = 0; m < 4; ++m) { const float rs = rstd_of(pre[ai * 4 + m]);
#pragma unroll
                    for (int bj = 0; bj < 2; ++bj) *(u32x4*)(base + (size_t)(ai * 128 + m * 16) * 1024 + bj * 128) = pack8(acc[ai][bj][m][0] * rs, acc[ai][bj][m][1] * rs); }
            return;
        }
        bf16_t* base = KV + (size_t)(u.pm * 256 + rl0) * 1536 + u.pn * 256 + cl0;
        const int isv = u.pn >= 3, ckv = (u.pn % 3) * 256 + cl0;
        float* fo = nullptr;
        if (u.pm >= 64) fo = out + (isv ? O_VS : O_KS) + (size_t)((u.pm - 64) * 256 + rl0) * AW + ckv;
        else if ((u.pm & 7) >= 6) fo = out + (isv ? O_CVP : O_CKP) + (size_t)((u.pm >> 3) * 512 + ((u.pm & 7) - 6) * 256 + rl0) * AW + ckv;
#pragma unroll
        for (int ai = 0; ai < 2; ++ai)
#pragma unroll
            for (int m = 0; m < 4; ++m) { const float rs = rstd_of(pre[ai * 4 + m]);
#pragma unroll
                for (int bj = 0; bj < 2; ++bj) { const f32x4 v0 = acc[ai][bj][m][0] * rs, v1 = acc[ai][bj][m][1] * rs;
                    *(u32x4*)(base + (size_t)(ai * 128 + m * 16) * 1536 + bj * 128) = pack8(v0, v1);
                    if (fo) { float* f = fo + (size_t)(ai * 128 + m * 16) * AW + bj * 128; *(f32x4*)f = v0; *(f32x4*)(f + 4) = v1; } } }
    }
};
__device__ __forceinline__ float silu_f(float x) { return x * __builtin_amdgcn_rcpf(1.0f + __expf(-x)); }
struct EpiSwiGLU {
    static constexpr bool PERM = true, AFTER_DRAIN = false;
    bf16_t* H; const float* pre;
    __device__ __forceinline__ void operator()(AccRef acc, const pg8::Unit& u, int wr, int wc, int fr, int fq) const {
        const int r0 = u.pm * 256 + wr * 64 + fr;
        bf16_t* base = H + (size_t)r0 * DFF + u.pn * 128 + wc * 32 + 8 * fq;
#pragma unroll
        for (int ai = 0; ai < 2; ++ai)
#pragma unroll
            for (int m = 0; m < 4; ++m) { f32x4 v0, v1; const float rs = rstd_of(pre[ai * 4 + m]);
#pragma unroll
                for (int j = 0; j < 4; ++j) { v0[j] = silu_f(acc[ai][0][m][0][j] * rs) * (acc[ai][1][m][0][j] * rs); v1[j] = silu_f(acc[ai][0][m][1][j] * rs) * (acc[ai][1][m][1][j] * rs); }
                *(u32x4*)(base + (size_t)(ai * 128 + m * 16) * DFF) = pack8(v0, v1); }
    }
};
__device__ __forceinline__ f32x4 unpack4(u32x2 w) { f32x4 v; v[0] = __builtin_bit_cast(float, w.x << 16); v[1] = __builtin_bit_cast(float, w.x & 0xffff0000u); v[2] = __builtin_bit_cast(float, w.y << 16); v[3] = __builtin_bit_cast(float, w.y & 0xffff0000u); return v; }
struct EpiResid {
    static constexpr bool PERM = false, AFTER_DRAIN = false;
    const float* basef; const bf16_t* baseh; float* Xf; bf16_t* XN; float* ss; bf16_t* PART; float sc;
    __device__ __forceinline__ void operator()(AccRef acc, const pg8::Unit& u, int wr, int wc, int fr, int fq) const {
        const int col0 = u.pn * 256 + wc * 32 + 4 * fq;
        if (u.pm >= 64) {
            bf16_t* pb = PART + ((size_t)u.sp * NS + (u.pm - 64) * 256 + wr * 64 + fr) * DM + col0;
#pragma unroll
            for (int ai = 0; ai < 2; ++ai)
#pragma unroll
                for (int m = 0; m < 4; ++m)
#pragma unroll
                    for (int bj = 0; bj < 2; ++bj)
#pragma unroll
                        for (int n = 0; n < 2; ++n) { const f32x4 v = acc[ai][bj][m][n] * sc; u32x2 w; w.x = cvt_pk_bf16(v[0], v[1]); w.y = cvt_pk_bf16(v[2], v[3]);
                            *(u32x2*)(pb + (size_t)(ai * 128 + m * 16) * DM + bj * 128 + n * 16) = w; }
            return;
        }
#pragma unroll
        for (int ai = 0; ai < 2; ++ai)
#pragma unroll
            for (int m = 0; m < 4; ++m) { const int r = u.pm * 256 + ai * 128 + wr * 64 + m * 16 + fr; const size_t off = (size_t)r * DM + col0; float sq = 0.f;
                f32x4 bv[2][2];
#pragma unroll
                for (int bj = 0; bj < 2; ++bj)
#pragma unroll
                    for (int n = 0; n < 2; ++n) bv[bj][n] = basef ? *(const f32x4*)(basef + off + bj * 128 + n * 16) : unpack4(*(const u32x2*)(baseh + off + bj * 128 + n * 16));
#pragma unroll
                for (int bj = 0; bj < 2; ++bj)
#pragma unroll
                    for (int n = 0; n < 2; ++n) { const f32x4 v = bv[bj][n] + acc[ai][bj][m][n] * sc;
                        if (Xf) *(f32x4*)(Xf + off + bj * 128 + n * 16) = v;
                        sq += (v[0] * v[0] + v[1] * v[1]) + (v[2] * v[2] + v[3] * v[3]);
                        if (XN) { u32x2 w; w.x = cvt_pk_bf16(v[0], v[1]); w.y = cvt_pk_bf16(v[2], v[3]); *(u32x2*)(XN + off + bj * 128 + n * 16) = w; } }
                if (ss) { sq += __shfl_xor(sq, 16); sq += __shfl_xor(sq, 32); if (fq == 0) __hip_atomic_fetch_add(ss + r, sq * sc, __ATOMIC_RELAXED, __HIP_MEMORY_SCOPE_AGENT); }
                if (m & 1) asm volatile("" ::: "memory"); }
    }
};
template <class Epi> __device__ __forceinline__ void run_gemm(LAS unsigned char* lds, const bf16_t* A, const bf16_t* Bt, int M, int N, int K, const Epi& E) {
    pg8::Gemm g{A, Bt, M, N, K}; pg8::StaticOrder S; S.init(M, N, K, (int)gridDim.x, (int)blockIdx.x);
    pg8::gemm_phase<Epi, pg8::StaticOrder, true, true>(lds, g, S, E);
}
template <class Epi> __device__ __forceinline__ void run_gemm_ss(LAS unsigned char* lds, const bf16_t* A, const bf16_t* Bt, int M, int N, int K, Epi E, const float* ss) {
    pg8::Gemm g{A, Bt, M, N, K}; pg8::StaticOrder S; S.init(M, N, K, (int)gridDim.x, (int)blockIdx.x); S.ssrc = ss; E.pre = S.pre;
    pg8::gemm_phase<Epi, pg8::StaticOrder, true, true>(lds, g, S, E);
}
__device__ __forceinline__ void run_gemm_resid(LAS unsigned char* lds, const bf16_t* A, const bf16_t* Bt, int K, const EpiResid& E) {
    pg8::Gemm g{A, Bt, MT, 1024, K}; pg8::ResidOrder S; S.init(K, (int)gridDim.x, (int)blockIdx.x);
    pg8::gemm_phase<EpiResid, pg8::ResidOrder, false, true>(lds, g, S, E);
}
__device__ __forceinline__ float reduce_row_regs(const float* browf, const bf16_t* browh, const bf16_t* PART, int srow, int lane, f32x4 (&v)[4]) {
    float s = 0.f;
#pragma unroll
    for (int j = 0; j < 4; ++j) v[j] = browf ? ((const f32x4*)browf)[lane + 64 * j] : unpack4(((const u32x2*)browh)[lane + 64 * j]);
#pragma unroll
    for (int sp = 0; sp < NSPLIT; ++sp) { const u32x2* p = (const u32x2*)(PART + ((size_t)sp * NS + srow) * DM) + lane;
#pragma unroll
        for (int j = 0; j < 4; ++j) v[j] += unpack4(p[64 * j]); }
#pragma unroll
    for (int j = 0; j < 4; ++j) s += (v[j][0] * v[j][0] + v[j][1] * v[j][1]) + (v[j][2] * v[j][2] + v[j][3] * v[j][3]);
    return wave_sum(s);
}
__device__ __forceinline__ void reduce_row(const float* browf, const bf16_t* browh, const bf16_t* PART, int srow, bf16_t* xnrow, float* ssp, int lane) {
    f32x4 v[4]; const float s = reduce_row_regs(browf, browh, PART, srow, lane, v);
#pragma unroll
    for (int j = 0; j < 4; ++j) { u32x2 w; w.x = cvt_pk_bf16(v[j][0], v[j][1]); w.y = cvt_pk_bf16(v[j][2], v[j][3]); ((u32x2*)xnrow)[lane + 64 * j] = w; }
    if (lane == 0) *ssp = s;
}

__device__ __forceinline__ void transpose_item(const float* W, int N, const float* g, bf16_t* WT, int K, int k0, int n0, int drow0, LAS float* scr, int lane) {
#pragma unroll 8
    for (int i = 0; i < 32; ++i) { const int kk = 2 * i + (lane >> 5); float v = W[(size_t)(k0 + kk) * N + n0 + (lane & 31)]; if (g) v *= g[k0 + kk]; scr[kk * 33 + (lane & 31)] = v; }
    LDS_WAIT();
    const int c = lane & 7;
#pragma unroll
    for (int j = 0; j < 4; ++j) { const int n = (lane >> 3) + 8 * j; const LAS float* s = scr + (8 * c) * 33 + n;
        u32x4 o; o.x = cvt_pk_bf16(s[0 * 33], s[1 * 33]); o.y = cvt_pk_bf16(s[2 * 33], s[3 * 33]); o.z = cvt_pk_bf16(s[4 * 33], s[5 * 33]); o.w = cvt_pk_bf16(s[6 * 33], s[7 * 33]);
        *(u32x4*)(WT + (size_t)(drow0 + n) * K + k0 + 8 * c) = o; }
    LDS_WAIT();
}
__device__ __forceinline__ void norm_row_bf16(const float* xrow, bf16_t* orow, int lane) {
    const f32x4* xr = (const f32x4*)xrow + lane; f32x4 v[4]; float s = 0.f;
#pragma unroll
    for (int j = 0; j < 4; ++j) { v[j] = xr[64 * j]; s += (v[j][0] * v[j][0] + v[j][1] * v[j][1]) + (v[j][2] * v[j][2] + v[j][3] * v[j][3]); }
    const float rstd = 1.0f / sqrtf(wave_sum(s) * (1.0f / DM) + RMS_EPS);
    u32x2* o8 = (u32x2*)orow + lane;
#pragma unroll
    for (int j = 0; j < 4; ++j) { u32x2 w; w.x = cvt_pk_bf16(v[j][0] * rstd, v[j][1] * rstd); w.y = cvt_pk_bf16(v[j][2] * rstd, v[j][3] * rstd); o8[64 * j] = w; }
}
__device__ __forceinline__ void norm_row2_bf16(const float* xrow, bf16_t* orow, float* ssp, int lane) {
    const f32x4* xr = (const f32x4*)xrow + lane; f32x4 v[8]; float s0 = 0.f, s1 = 0.f;
#pragma unroll
    for (int j = 0; j < 8; ++j) v[j] = xr[64 * j];
#pragma unroll
    for (int j = 0; j < 4; ++j) { s0 += (v[j][0] * v[j][0] + v[j][1] * v[j][1]) + (v[j][2] * v[j][2] + v[j][3] * v[j][3]); s1 += (v[4 + j][0] * v[4 + j][0] + v[4 + j][1] * v[4 + j][1]) + (v[4 + j][2] * v[4 + j][2] + v[4 + j][3] * v[4 + j][3]); }
    s0 = wave_sum(s0); s1 = wave_sum(s1);
    float r0 = 1.0f, r1 = 1.0f;
    if (ssp) { if (lane == 0) { ssp[0] = s0; ssp[1] = s1; } } else { r0 = 1.0f / sqrtf(s0 * (1.0f / DM) + RMS_EPS); r1 = 1.0f / sqrtf(s1 * (1.0f / DM) + RMS_EPS); }
    u32x2* o8 = (u32x2*)orow + lane;
#pragma unroll
    for (int j = 0; j < 8; ++j) { const float rs = j < 4 ? r0 : r1; u32x2 w; w.x = cvt_pk_bf16(v[j][0] * rs, v[j][1] * rs); w.y = cvt_pk_bf16(v[j][2] * rs, v[j][3] * rs); o8[64 * j] = w; }
}
__device__ __forceinline__ void norm_row2_final_h(const bf16_t* xrow, float* yrow, const float* g, int lane) {
    const u32x2* xr = (const u32x2*)xrow + lane; const f32x4* gr = (const f32x4*)g + lane; u32x2 w[8]; f32x4 v[8]; float s0 = 0.f, s1 = 0.f;
#pragma unroll
    for (int j = 0; j < 8; ++j) w[j] = xr[64 * j];
#pragma unroll
    for (int j = 0; j < 8; ++j) { v[j][0] = __builtin_bit_cast(float, w[j].x << 16); v[j][1] = __builtin_bit_cast(float, w[j].x & 0xffff0000u); v[j][2] = __builtin_bit_cast(float, w[j].y << 16); v[j][3] = __builtin_bit_cast(float, w[j].y & 0xffff0000u);
        const float q = (v[j][0] * v[j][0] + v[j][1] * v[j][1]) + (v[j][2] * v[j][2] + v[j][3] * v[j][3]); if (j < 4) s0 += q; else s1 += q; }
    const float r0 = 1.0f / sqrtf(wave_sum(s0) * (1.0f / DM) + RMS_EPS), r1 = 1.0f / sqrtf(wave_sum(s1) * (1.0f / DM) + RMS_EPS);
#pragma unroll
    for (int j = 0; j < 8; ++j) ((f32x4*)yrow)[lane + 64 * j] = v[j] * (j < 4 ? r0 : r1) * gr[64 * (j & 3)];
}
__device__ __forceinline__ void norm_row_final_h(const bf16_t* xrow, float* yrow, const float* g, int lane) {
    const u32x2* xr = (const u32x2*)xrow + lane; const f32x4* gr = (const f32x4*)g + lane; f32x4 v[4]; float s = 0.f;
#pragma unroll
    for (int j = 0; j < 4; ++j) { const u32x2 w = xr[64 * j]; v[j][0] = __builtin_bit_cast(float, w.x << 16); v[j][1] = __builtin_bit_cast(float, w.x & 0xffff0000u); v[j][2] = __builtin_bit_cast(float, w.y << 16); v[j][3] = __builtin_bit_cast(float, w.y & 0xffff0000u);
        s += (v[j][0] * v[j][0] + v[j][1] * v[j][1]) + (v[j][2] * v[j][2] + v[j][3] * v[j][3]); }
    const float rstd = 1.0f / sqrtf(wave_sum(s) * (1.0f / DM) + RMS_EPS);
#pragma unroll
    for (int j = 0; j < 4; ++j) ((f32x4*)yrow)[lane + 64 * j] = v[j] * rstd * gr[64 * j];
}
__device__ __forceinline__ void norm_row_final(float* xrow, const float* g, int lane) {
    f32x4* xr = (f32x4*)xrow + lane; const f32x4* gr = (const f32x4*)g + lane; f32x4 v[4]; float s = 0.f;
#pragma unroll
    for (int j = 0; j < 4; ++j) { v[j] = xr[64 * j]; s += (v[j][0] * v[j][0] + v[j][1] * v[j][1]) + (v[j][2] * v[j][2] + v[j][3] * v[j][3]); }
    const float rstd = 1.0f / sqrtf(wave_sum(s) * (1.0f / DM) + RMS_EPS);
#pragma unroll
    for (int j = 0; j < 4; ++j) xr[64 * j] = v[j] * rstd * gr[64 * j];
}

struct Args { const float* in[29]; float* out; unsigned char* ws; int ph_lo, ph_hi; int flags, pad; };


constexpr int I_INA = 16 * 56, I_KV = 16 * 48, I_INB = 16 * 32, I_MEM = 16 * 16, I_OUT = 16 * 32, I_GU = 16 * 176, I_DN = 44 * 32;
constexpr int W_EARLY = I_INA + 2 * I_MEM;
constexpr int W_ALL = W_EARLY + I_KV + I_INB + 2 * I_OUT + 2 * I_GU + 2 * I_DN;
constexpr int WB_KV = W_EARLY, WB_OUT = WB_KV + I_KV + I_INB, WB_GU = WB_OUT + 2 * I_OUT, WB_DN = WB_GU + 2 * I_GU;
constexpr int W_P1 = I_OUT + I_GU + I_DN;
constexpr int W_P6 = I_KV + I_INB + I_OUT + I_GU + I_DN;
__device__ __forceinline__ int witem_p1(int q) { if (q < I_OUT) return WB_OUT + q; q -= I_OUT; if (q < I_GU) return WB_GU + q; return WB_DN + (q - I_GU); }
__device__ __forceinline__ int witem_p6(int q) { if (q < I_KV + I_INB) return WB_KV + q; q -= I_KV + I_INB; if (q < I_OUT) return WB_OUT + I_OUT + q; q -= I_OUT; if (q < I_GU) return WB_GU + I_GU + q; return WB_DN + I_DN + (q - I_GU); }
__device__ __forceinline__ void weight_item(const Args& a, int r, LAS float* scr, int lane) {
    unsigned char* ws = a.ws;
    bf16_t* WINA = (bf16_t*)(ws + WS_WINA); bf16_t* WKVB = (bf16_t*)(ws + WS_WKVB); bf16_t* WMEM = (bf16_t*)(ws + WS_WMEM); bf16_t* WOUT = (bf16_t*)(ws + WS_WOUT);
    bf16_t* WGU = (bf16_t*)(ws + WS_WGU); bf16_t* WDN = (bf16_t*)(ws + WS_WDN);
    if (r < I_INA) { const int kb = r / 56, nb = r % 56; transpose_item(a.in[12], NINA, a.in[9], WINA, 1024, kb * 64, nb * 32, nb * 32, scr, lane); return; } r -= I_INA;
    if (r < 2 * I_MEM) { const int l = r / I_MEM; r %= I_MEM; const int kb = r / 16, nb = r % 16; transpose_item(a.in[25] + (size_t)l * 1024 * 512, 512, a.in[24] + l * 1024, WMEM, 1024, kb * 64, nb * 32, l * 512 + nb * 32, scr, lane); return; } r -= 2 * I_MEM;
    if (r < I_KV) { const int kb = r / 48, nb = r % 48; transpose_item(a.in[21], 1536, a.in[20], WKVB, 1024, kb * 64, nb * 32, nb * 32, scr, lane); return; } r -= I_KV;
    if (r < I_INB) { const int kb = r / 32, nb = r % 32; transpose_item(a.in[22], 1024, a.in[9] + 1024, WKVB, 1024, kb * 64, nb * 32, 1536 + nb * 32, scr, lane); return; } r -= I_INB;
    if (r < 2 * I_OUT) { const int l = r / I_OUT; r %= I_OUT; const int kb = r / 32, nb = r % 32; transpose_item(a.in[26] + (size_t)l * 1024 * 1024, 1024, nullptr, WOUT + (size_t)l * 1024 * 1024, 1024, kb * 64, nb * 32, nb * 32, scr, lane); return; } r -= 2 * I_OUT;
    if (r < 2 * I_GU) { const int l = r / I_GU; r %= I_GU; const int kb = r / 176, nb = r % 176; const int c = nb * 32, bj = c / DFF, cp = c % DFF;
        transpose_item(a.in[27] + (size_t)l * 1024 * 2 * DFF, 2 * DFF, a.in[10] + l * 1024, WGU + (size_t)l * 2 * DFF * 1024, 1024, kb * 64, c, 256 * (cp / 128) + 128 * bj + (cp % 128), scr, lane); return; } r -= 2 * I_GU;
    { const int l = r / I_DN; r %= I_DN; const int kb = r / 32, nb = r % 32; transpose_item(a.in[28] + (size_t)l * DFF * 1024, 1024, nullptr, WDN + (size_t)l * 1024 * DFF, DFF, kb * 64, nb * 32, nb * 32, scr, lane); }
}

__device__ __forceinline__ float sigmoid_f(float x) { return __builtin_amdgcn_rcpf(1.0f + __builtin_amdgcn_exp2f(-1.4426950408889634f * x)); }
__device__ __forceinline__ float gelu_tanh(float x) { const float t = (-1.5957691216057308f * 1.4426950408889634f) * (x + 0.044715f * x * x * x); return x * __builtin_amdgcn_rcpf(1.0f + __builtin_amdgcn_exp2f(t)); }
__device__ __forceinline__ float neg_expm1(float t, float av) {
    const float p = -t * (1.0f + t * (0.5f + t * (0.16666667f + t * (0.041666668f + t * (0.0083333338f + t * 0.0013888889f)))));
    return t > -0.25f ? p : 1.0f - av * av;
}
template <int PASS> __device__ __forceinline__ void scan_item(const Args& a, int chunk, int nb, LAS unsigned char* wl, int lane) {
    unsigned char* ws = a.ws;
    const bf16_t* PROJ = (const bf16_t*)(ws + WS_PROJ); bf16_t* MIX = (bf16_t*)(ws + WS_MIX);
    float* CA = (float*)(ws + WS_CAR); float* CH = CA + 256 * LW;
    const bf16_t* WGT = (const bf16_t*)(ws + WS_WG);
    const int cgi = nb * 64 + lane;
    const bool isp = chunk < 256; const int b = isp ? (chunk >> 5) : (chunk - 256), c = isp ? (chunk & 31) : 0;
    const int row0 = isp ? b * TP + c * 64 : NP + b * TS;
    const bf16_t* xp = PROJ + (size_t)row0 * NINA + cgi;
    const float w0 = a.in[13][0 * LW + cgi], w1 = a.in[13][1 * LW + cgi], w2 = a.in[13][2 * LW + cgi], w3 = a.in[13][3 * LW + cgi], cb = a.in[14][cgi];
    float xm1, xm2, xm3;
    if (isp) { if (c == 0) { xm1 = xm2 = xm3 = 0.f; } else { xm3 = bf2f(*(xp - 3 * NINA)); xm2 = bf2f(*(xp - 2 * NINA)); xm1 = bf2f(*(xp - NINA)); } }
    else { const float* sc = a.in[2] + (size_t)b * 3 * LW + cgi; xm3 = sc[0]; xm2 = sc[LW]; xm1 = sc[2 * LW]; }
    const float lam = a.in[19][cgi]; const float c8 = -8.0f * log1pf(__expf(-lam));
    const float ba = a.in[16][cgi], bi = a.in[18][cgi];
    const int fr = lane & 15, fq = lane >> 4;
    bf16x8 wa[4][2], wi[4][2];
#pragma unroll
    for (int jb = 0; jb < 4; ++jb)
#pragma unroll
        for (int kb = 0; kb < 2; ++kb) {
            wa[jb][kb] = *(const bf16x8*)(WGT + (size_t)((0 * 12 + nb) * 64 + jb * 16 + fr) * 64 + kb * 32 + fq * 8);
            wi[jb][kb] = *(const bf16x8*)(WGT + (size_t)((1 * 12 + nb) * 64 + jb * 16 + fr) * 64 + kb * 32 + fq * 8); }
    LAS bf16_t* xcT = (LAS bf16_t*)wl;
    LAS float* Ab = (LAS float*)(wl + 2304);
    LAS float* Gb = (LAS float*)(wl + 6656);
    float h = 0.f, ap = 1.f;
    if (PASS == 2) {
        if (isp) { const float* pa = CA + (size_t)(b * 32) * LW + cgi; const float* ph = CH + (size_t)(b * 32) * LW + cgi;
            for (int cq = 0; cq < c; cq += 8) { float av[8], hv[8];
#pragma unroll
                for (int k = 0; k < 8; ++k) { const int cc = (cq + k < c) ? cq + k : c - 1; av[k] = pa[(size_t)cc * LW]; hv[k] = ph[(size_t)cc * LW]; }
#pragma unroll
                for (int k = 0; k < 8; ++k) if (cq + k < c) h = av[k] * h + hv[k]; } }
        else h = a.in[3][(size_t)b * LW + cgi];
    }
    const bool reset = isp && c == 0;
    LAS bf16_t* xs = (LAS bf16_t*)(wl + 11264); LAS bf16_t* gs = (LAS bf16_t*)(wl + 13312);
    const int lr = lane >> 3, lp = lane & 7;
    const bf16_t* tp0 = PROJ + (size_t)(row0 + lr) * NINA + nb * 64 + lp * 8;
    u32x4 px0 = *(const u32x4*)tp0, px1 = *(const u32x4*)(tp0 + (size_t)8 * NINA), pg0, pg1;
    if (PASS == 2) { pg0 = *(const u32x4*)(tp0 + LW); pg1 = *(const u32x4*)(tp0 + (size_t)8 * NINA + LW); }
    *(LAS u32x4*)(xs + lr * 64 + lp * 8) = px0; *(LAS u32x4*)(xs + (lr + 8) * 64 + lp * 8) = px1;
    if (PASS == 2) { *(LAS u32x4*)(gs + lr * 64 + lp * 8) = pg0; *(LAS u32x4*)(gs + (lr + 8) * 64 + lp * 8) = pg1; }
    LDS_WAIT();
    const float ban = -LOG2E * ba, bin = -LOG2E * bi, c8l = c8 * LOG2E, c8x2 = 2.0f * c8;
    constexpr float GK1 = -1.5957691216057308f * LOG2E, GK3 = GK1 * 0.044715f;
#pragma unroll 1
    for (int tb = 0; tb < 4; ++tb) {
        f32x2v xc2[8];
        if (tb < 3) { const bf16_t* tpn = tp0 + (size_t)((tb + 1) * 16) * NINA;
            px0 = *(const u32x4*)tpn; px1 = *(const u32x4*)(tpn + (size_t)8 * NINA);
            if (PASS == 2) { pg0 = *(const u32x4*)(tpn + LW); pg1 = *(const u32x4*)(tpn + (size_t)8 * NINA + LW); } }
        asm volatile("" ::: "memory");
#pragma unroll
        for (int tp = 0; tp < 8; ++tp) {
            const float x0 = bf2f(xs[(2 * tp) * 64 + lane]), x1 = bf2f(xs[(2 * tp + 1) * 64 + lane]);
            const f32x2v xa = {x0, x1}, xb = {xm1, x0}, xcv = {xm2, xm1}, xd = {xm3, xm2};
            const f32x2v v = cb + w3 * xa + w2 * xb + w1 * xcv + w0 * xd;
            xc2[tp] = v; xm3 = xm1; xm2 = x0; xm1 = x1;
            const unsigned pk = cvt_pk_bf16(v.x, v.y);
            xcT[(2 * tp) * 72 + lane] = (bf16_t)(pk & 0xffffu); xcT[(2 * tp + 1) * 72 + lane] = (bf16_t)(pk >> 16);
        }
        LDS_WAIT();
        bf16x8 xf[2];
#pragma unroll
        for (int kb = 0; kb < 2; ++kb) xf[kb] = *(const LAS bf16x8*)(xcT + fr * 72 + kb * 32 + fq * 8);
#pragma unroll
        for (int jb = 0; jb < 4; ++jb) {
            f32x4 ar = {0.f, 0.f, 0.f, 0.f}, ai = {0.f, 0.f, 0.f, 0.f};
            ar = __builtin_amdgcn_mfma_f32_16x16x32_bf16(wa[jb][0], xf[0], ar, 0, 0, 0); ar = __builtin_amdgcn_mfma_f32_16x16x32_bf16(wa[jb][1], xf[1], ar, 0, 0, 0);
            ai = __builtin_amdgcn_mfma_f32_16x16x32_bf16(wi[jb][0], xf[0], ai, 0, 0, 0); ai = __builtin_amdgcn_mfma_f32_16x16x32_bf16(wi[jb][1], xf[1], ai, 0, 0, 0);
            *(LAS f32x4*)(Ab + fr * 68 + jb * 16 + 4 * fq) = ar; *(LAS f32x4*)(Gb + fr * 68 + jb * 16 + 4 * fq) = ai;
        }
        LDS_WAIT();
#pragma unroll
        for (int tp = 0; tp < 8; ++tp) {
            const f32x2v za = (f32x2v){Ab[(2 * tp) * 68 + lane], Ab[(2 * tp + 1) * 68 + lane]} + ban, zi = (f32x2v){Gb[(2 * tp) * 68 + lane], Gb[(2 * tp + 1) * 68 + lane]} + bin;
            const f32x2v da = (f32x2v){__builtin_amdgcn_exp2f(za.x), __builtin_amdgcn_exp2f(za.y)} + 1.0f, di = (f32x2v){__builtin_amdgcn_exp2f(zi.x), __builtin_amdgcn_exp2f(zi.y)} + 1.0f;
            const f32x2v r = {__builtin_amdgcn_rcpf(da.x), __builtin_amdgcn_rcpf(da.y)}, ig = {__builtin_amdgcn_rcpf(di.x), __builtin_amdgcn_rcpf(di.y)};
            const f32x2v lal = c8l * r, t = c8x2 * r;
            const f32x2v av = {__builtin_amdgcn_exp2f(lal.x), __builtin_amdgcn_exp2f(lal.y)};
            const f32x2v pl = -t * (1.0f + t * (0.5f + t * (0.16666667f + t * (0.041666668f + t * (0.0083333338f + t * 0.0013888889f)))));
            const f32x2v em = 1.0f - av * av;
            f32x2v mult = {__builtin_amdgcn_sqrtf(t.x > -0.25f ? pl.x : em.x), __builtin_amdgcn_sqrtf(t.y > -0.25f ? pl.y : em.y)};
            if (tp == 0) { if (reset && tb == 0) mult.x = 1.0f; }
            const f32x2v u = mult * ig * xc2[tp];
            const float h0 = av.x * h + u.x, h1 = av.y * h0 + u.y; h = h1;
            if (PASS == 1) ap *= av.x * av.y;
            if (PASS == 2) {
                const f32x2v g = {bf2f(gs[(2 * tp) * 64 + lane]), bf2f(gs[(2 * tp + 1) * 64 + lane])};
                const f32x2v tn = g * (GK1 + GK3 * (g * g));
                const f32x2v dg = (f32x2v){__builtin_amdgcn_exp2f(tn.x), __builtin_amdgcn_exp2f(tn.y)} + 1.0f;
                const f32x2v o = (f32x2v){h0, h1} * g * (f32x2v){__builtin_amdgcn_rcpf(dg.x), __builtin_amdgcn_rcpf(dg.y)};
                const unsigned pk = cvt_pk_bf16(o.x, o.y); bf16_t* mp = MIX + (size_t)(row0 + tb * 16 + 2 * tp) * DM + cgi;
                mp[0] = (bf16_t)(pk & 0xffffu); mp[DM] = (bf16_t)(pk >> 16);
            }
        }
        LDS_WAIT();
        if (tb < 3) {
            *(LAS u32x4*)(xs + lr * 64 + lp * 8) = px0; *(LAS u32x4*)(xs + (lr + 8) * 64 + lp * 8) = px1;
            if (PASS == 2) { *(LAS u32x4*)(gs + lr * 64 + lp * 8) = pg0; *(LAS u32x4*)(gs + (lr + 8) * 64 + lp * 8) = pg1; }
            LDS_WAIT();
        }
    }
    if (PASS == 1) { CA[(size_t)chunk * LW + cgi] = ap; CH[(size_t)chunk * LW + cgi] = h; }
    if (PASS == 2) {
        if (isp && c == 31) { float* o = a.out; o[O_LRUP + (size_t)b * LW + cgi] = h; o[O_CONVP + (size_t)(b * 3 + 0) * LW + cgi] = xm3; o[O_CONVP + (size_t)(b * 3 + 1) * LW + cgi] = xm2; o[O_CONVP + (size_t)(b * 3 + 2) * LW + cgi] = xm1; }
        if (!isp) { float* o = a.out; o[O_LRUS + (size_t)b * LW + cgi] = h; o[O_CONVS + (size_t)(b * 3 + 0) * LW + cgi] = xm3; o[O_CONVS + (size_t)(b * 3 + 1) * LW + cgi] = xm2; o[O_CONVS + (size_t)(b * 3 + 2) * LW + cgi] = xm1; }
    }
}


__device__ __forceinline__ void scan_onepass(const Args& a, int chunk, int nb, LAS unsigned char* wl, int lane) {
    unsigned char* ws = a.ws;
    const bf16_t* PROJ = (const bf16_t*)(ws + WS_PROJ); bf16_t* MIX = (bf16_t*)(ws + WS_MIX);
    unsigned long long* CAR = (unsigned long long*)(ws + WS_CAR);
    const bf16_t* WGT = (const bf16_t*)(ws + WS_WG);
    const int cgi = nb * 64 + lane;
    const bool isp = chunk < 256; const int b = isp ? (chunk >> 5) : (chunk - 256), c = isp ? (chunk & 31) : 0;
    const int row0 = isp ? b * TP + c * 64 : NP + b * TS;
    const bf16_t* xp = PROJ + (size_t)row0 * NINA + cgi;
    const float w0 = a.in[13][0 * LW + cgi], w1 = a.in[13][1 * LW + cgi], w2 = a.in[13][2 * LW + cgi], w3 = a.in[13][3 * LW + cgi], cb = a.in[14][cgi];
    float xm1, xm2, xm3;
    if (isp) { if (c == 0) { xm1 = xm2 = xm3 = 0.f; } else { xm3 = bf2f(*(xp - 3 * NINA)); xm2 = bf2f(*(xp - 2 * NINA)); xm1 = bf2f(*(xp - NINA)); } }
    else { const float* sc = a.in[2] + (size_t)b * 3 * LW + cgi; xm3 = sc[0]; xm2 = sc[LW]; xm1 = sc[2 * LW]; }
    const float lam = a.in[19][cgi]; const float c8 = -8.0f * log1pf(__expf(-lam));
    const float ban = -LOG2E * a.in[16][cgi], bin = -LOG2E * a.in[18][cgi], c8l = c8 * LOG2E, c8x2 = 2.0f * c8;
    constexpr float GK1 = -1.5957691216057308f * LOG2E, GK3 = GK1 * 0.044715f;
    const int fr = lane & 15, fq = lane >> 4;
    LAS bf16_t* xcT = (LAS bf16_t*)wl; LAS float* Ab = (LAS float*)(wl + 2304); LAS float* Gb = (LAS float*)(wl + 6656);
    LAS bf16_t* xs = (LAS bf16_t*)(wl + 11264); LAS bf16_t* gs = (LAS bf16_t*)(wl + 13312);
    const int lr = lane >> 3, lp = lane & 7;
    const bf16_t* tp0 = PROJ + (size_t)(row0 + lr) * NINA + nb * 64 + lp * 8;
    const bool reset = isp && c == 0;
    f32x2v aa[32], uu[32];
    float hl = 0.f, ap = 1.f;
    {
        bf16x8 wa[4][2], wi[4][2];
#pragma unroll
        for (int jb = 0; jb < 4; ++jb)
#pragma unroll
            for (int kb = 0; kb < 2; ++kb) {
                wa[jb][kb] = *(const bf16x8*)(WGT + (size_t)((0 * 12 + nb) * 64 + jb * 16 + fr) * 64 + kb * 32 + fq * 8);
                wi[jb][kb] = *(const bf16x8*)(WGT + (size_t)((1 * 12 + nb) * 64 + jb * 16 + fr) * 64 + kb * 32 + fq * 8); }
        u32x4 px0 = *(const u32x4*)tp0, px1 = *(const u32x4*)(tp0 + (size_t)8 * NINA);
        *(LAS u32x4*)(xs + lr * 64 + lp * 8) = px0; *(LAS u32x4*)(xs + (lr + 8) * 64 + lp * 8) = px1;
        LDS_WAIT();
#pragma unroll
        for (int tb = 0; tb < 4; ++tb) {
            f32x2v xc2[8];
            if (tb < 3) { const bf16_t* tpn = tp0 + (size_t)((tb + 1) * 16) * NINA; px0 = *(const u32x4*)tpn; px1 = *(const u32x4*)(tpn + (size_t)8 * NINA); }
            asm volatile("" ::: "memory");
#pragma unroll
            for (int tp = 0; tp < 8; ++tp) {
                const float x0 = bf2f(xs[(2 * tp) * 64 + lane]), x1 = bf2f(xs[(2 * tp + 1) * 64 + lane]);
                const f32x2v xa = {x0, x1}, xb = {xm1, x0}, xcv = {xm2, xm1}, xd = {xm3, xm2};
                const f32x2v v = cb + w3 * xa + w2 * xb + w1 * xcv + w0 * xd;
                xc2[tp] = v; xm3 = xm1; xm2 = x0; xm1 = x1;
                const unsigned pk = cvt_pk_bf16(v.x, v.y);
                xcT[(2 * tp) * 72 + lane] = (bf16_t)(pk & 0xffffu); xcT[(2 * tp + 1) * 72 + lane] = (bf16_t)(pk >> 16);
            }
            LDS_WAIT();
            bf16x8 xf[2];
#pragma unroll
            for (int kb = 0; kb < 2; ++kb) xf[kb] = *(const LAS bf16x8*)(xcT + fr * 72 + kb * 32 + fq * 8);
#pragma unroll
            for (int jb = 0; jb < 4; ++jb) {
                f32x4 ar = {0.f, 0.f, 0.f, 0.f}, ai = {0.f, 0.f, 0.f, 0.f};
                ar = __builtin_amdgcn_mfma_f32_16x16x32_bf16(wa[jb][0], xf[0], ar, 0, 0, 0); ar = __builtin_amdgcn_mfma_f32_16x16x32_bf16(wa[jb][1], xf[1], ar, 0, 0, 0);
                ai = __builtin_amdgcn_mfma_f32_16x16x32_bf16(wi[jb][0], xf[0], ai, 0, 0, 0); ai = __builtin_amdgcn_mfma_f32_16x16x32_bf16(wi[jb][1], xf[1], ai, 0, 0, 0);
                *(LAS f32x4*)(Ab + fr * 68 + jb * 16 + 4 * fq) = ar; *(LAS f32x4*)(Gb + fr * 68 + jb * 16 + 4 * fq) = ai;
            }
            LDS_WAIT();
#pragma unroll
            for (int tp = 0; tp < 8; ++tp) {
                const f32x2v za = (f32x2v){Ab[(2 * tp) * 68 + lane], Ab[(2 * tp + 1) * 68 + lane]} + ban, zi = (f32x2v){Gb[(2 * tp) * 68 + lane], Gb[(2 * tp + 1) * 68 + lane]} + bin;
                const f32x2v da = (f32x2v){__builtin_amdgcn_exp2f(za.x), __builtin_amdgcn_exp2f(za.y)} + 1.0f, di = (f32x2v){__builtin_amdgcn_exp2f(zi.x), __builtin_amdgcn_exp2f(zi.y)} + 1.0f;
                const f32x2v r = {__builtin_amdgcn_rcpf(da.x), __builtin_amdgcn_rcpf(da.y)}, ig = {__builtin_amdgcn_rcpf(di.x), __builtin_amdgcn_rcpf(di.y)};
                const f32x2v lal = c8l * r, t = c8x2 * r;
                const f32x2v av = {__builtin_amdgcn_exp2f(lal.x), __builtin_amdgcn_exp2f(lal.y)};
                const f32x2v pl = -t * (1.0f + t * (0.5f + t * (0.16666667f + t * (0.041666668f + t * (0.0083333338f + t * 0.0013888889f)))));
                const f32x2v em = 1.0f - av * av;
                f32x2v mult = {__builtin_amdgcn_sqrtf(t.x > -0.25f ? pl.x : em.x), __builtin_amdgcn_sqrtf(t.y > -0.25f ? pl.y : em.y)};
                if (tb == 0 && tp == 0) { if (reset) mult.x = 1.0f; }
                const f32x2v u = mult * ig * xc2[tp];
                aa[tb * 8 + tp] = av; uu[tb * 8 + tp] = u;
                hl = av.x * hl + u.x; hl = av.y * hl + u.y; ap *= av.x * av.y;
            }
            LDS_WAIT();
            if (tb < 3) { *(LAS u32x4*)(xs + lr * 64 + lp * 8) = px0; *(LAS u32x4*)(xs + (lr + 8) * 64 + lp * 8) = px1; LDS_WAIT(); }
        }
    }
    if (isp && c < 31) { const unsigned long long pk = ((unsigned long long)__builtin_bit_cast(unsigned, hl) << 32) | (unsigned long long)__builtin_bit_cast(unsigned, ap);
        __hip_atomic_store(CAR + (size_t)chunk * LW + cgi, pk, __ATOMIC_RELAXED, __HIP_MEMORY_SCOPE_AGENT); }
    u32x4 pg0 = *(const u32x4*)(tp0 + LW), pg1 = *(const u32x4*)(tp0 + (size_t)8 * NINA + LW);
    float h = 0.f;
    if (isp) { unsigned long long* pc = CAR + (size_t)(b * 32) * LW + cgi;
        for (int cq = 0; cq < c; cq += 8) { unsigned long long v[8];
#pragma unroll
            for (int k = 0; k < 8; ++k) { const int cc = (cq + k < c) ? cq + k : c - 1; v[k] = __hip_atomic_load(pc + (size_t)cc * LW, __ATOMIC_RELAXED, __HIP_MEMORY_SCOPE_AGENT); }
#pragma unroll
            for (int k = 0; k < 8; ++k) { const int cc = (cq + k < c) ? cq + k : c - 1; unsigned sp = 0;
                while (v[k] == ~0ull && ++sp < (1u << 20)) { __builtin_amdgcn_s_sleep(2); v[k] = __hip_atomic_load(pc + (size_t)cc * LW, __ATOMIC_RELAXED, __HIP_MEMORY_SCOPE_AGENT); }
                if (cq + k < c) h = __builtin_bit_cast(float, (unsigned)v[k]) * h + __builtin_bit_cast(float, (unsigned)(v[k] >> 32)); } } }
    else h = a.in[3][(size_t)b * LW + cgi];
    *(LAS u32x4*)(gs + lr * 64 + lp * 8) = pg0; *(LAS u32x4*)(gs + (lr + 8) * 64 + lp * 8) = pg1;
    LDS_WAIT();
#pragma unroll
    for (int tb = 0; tb < 4; ++tb) {
        if (tb < 3) { const bf16_t* tpn = tp0 + (size_t)((tb + 1) * 16) * NINA + LW; pg0 = *(const u32x4*)tpn; pg1 = *(const u32x4*)(tpn + (size_t)8 * NINA); }
        asm volatile("" ::: "memory");
#pragma unroll
        for (int tp = 0; tp < 8; ++tp) {
            const f32x2v av = aa[tb * 8 + tp], u = uu[tb * 8 + tp];
            const float h0 = av.x * h + u.x, h1 = av.y * h0 + u.y; h = h1;
            const f32x2v g = {bf2f(gs[(2 * tp) * 64 + lane]), bf2f(gs[(2 * tp + 1) * 64 + lane])};
            const f32x2v tn = g * (GK1 + GK3 * (g * g));
            const f32x2v dg = (f32x2v){__builtin_amdgcn_exp2f(tn.x), __builtin_amdgcn_exp2f(tn.y)} + 1.0f;
            const f32x2v o = (f32x2v){h0, h1} * g * (f32x2v){__builtin_amdgcn_rcpf(dg.x), __builtin_amdgcn_rcpf(dg.y)};
            const unsigned pk = cvt_pk_bf16(o.x, o.y); bf16_t* mp = MIX + (size_t)(row0 + tb * 16 + 2 * tp) * DM + cgi;
            mp[0] = (bf16_t)(pk & 0xffffu); mp[DM] = (bf16_t)(pk >> 16);
        }
        LDS_WAIT();
        if (tb < 3) { *(LAS u32x4*)(gs + lr * 64 + lp * 8) = pg0; *(LAS u32x4*)(gs + (lr + 8) * 64 + lp * 8) = pg1; LDS_WAIT(); }
    }
    if (isp && c == 31) { float* o = a.out; o[O_LRUP + (size_t)b * LW + cgi] = h; o[O_CONVP + (size_t)(b * 3 + 0) * LW + cgi] = xm3; o[O_CONVP + (size_t)(b * 3 + 1) * LW + cgi] = xm2; o[O_CONVP + (size_t)(b * 3 + 2) * LW + cgi] = xm1; }
    if (!isp) { float* o = a.out; o[O_LRUS + (size_t)b * LW + cgi] = h; o[O_CONVS + (size_t)(b * 3 + 0) * LW + cgi] = xm3; o[O_CONVS + (size_t)(b * 3 + 1) * LW + cgi] = xm2; o[O_CONVS + (size_t)(b * 3 + 2) * LW + cgi] = xm1; }
}

__device__ __forceinline__ void attn_bias_tables(const Args& a, LAS unsigned char* lds) {
    LAS float* T = (LAS float*)(lds + 36864);
    for (int e = threadIdx.x; e < 12 * 1568; e += 512) { const int h = e / 1568, rem = e % 1568, sft = rem / 392, jj = rem % 392; int i = jj - 64 + sft; i = i < 0 ? 0 : (i > 319 ? 319 : i); T[e] = a.in[23][(size_t)(512 - i) * 12 + h] * 8.0f; }
}
enum { AT_PB = 0, AT_SB = 1, AT_PM = 2, AT_SM = 3 };
__device__ __forceinline__ int crow(int r, int hi) { return (r & 3) + 8 * (r >> 2) + 4 * hi; }
struct IC0 { static constexpr int value = 0; }; struct IC1 { static constexpr int value = 1; };
__device__ __forceinline__ void attn_item(const Args& a, LAS unsigned char* lds, int mode, int idx, int layer) {
    unsigned char* ws = a.ws;
    const int tid = threadIdx.x, lane = tid & 63, wv = __builtin_amdgcn_readfirstlane(tid >> 6), q = lane & 31, hi = lane >> 5;
    const bf16_t* KVb = (const bf16_t*)(ws + WS_KV); const bf16_t* MKV = (const bf16_t*)(ws + WS_MKV);
    bf16_t* MIX = (bf16_t*)(ws + WS_MIX);
    const bf16_t* Qbuf = (const bf16_t*)(ws + WS_PROJ); const int qpitch = layer == 0 ? NINA : 1024;
    int h, b, row0, nact, j0, j1, c0 = 0, qcol, ocol;
    if (mode == AT_PB) { h = idx % 12; const int grp = idx / 12; b = grp >> 3; const int g8 = grp & 7; c0 = g8 * 4; row0 = b * TP + g8 * 256; nact = 8; j0 = c0 >= 8 ? 0 : 8 - c0; j1 = 11; qcol = h * 64; ocol = h * 64; }
    else if (mode == AT_SB) { h = idx % 12; b = idx / 12; row0 = NP + b * TS; nact = 2; j0 = 0; j1 = 8; qcol = h * 64; ocol = h * 64; }
    else if (mode == AT_PM) { h = idx & 3; const int grp = idx >> 2; b = grp >> 3; row0 = grp * 256; nact = 8; j0 = 0; j1 = 3; qcol = (layer == 0 ? 2 * LW : AW) + h * 64; ocol = AW + h * 64; }
    else { h = idx & 3; b = idx >> 2; row0 = NP + b * TS; nact = 2; j0 = 0; j1 = 3; qcol = (layer == 0 ? 2 * LW : AW) + h * 64; ocol = AW + h * 64; }
    const bool band = mode <= AT_SB, active = wv < nact;
    const int wofs = (mode == AT_PB) ? (wv >> 1) : 0;
    const int qi = ((mode == AT_PB) ? (wv & 1) * 32 : wv * 32) + q;
    LAS float* biasT = (LAS float*)(lds + 36864) + h * 1568;
    __syncthreads();
    bf16x8 qf[4];
    if (active) { const bf16_t* qp = Qbuf + (size_t)(row0 + wv * 32 + q) * qpitch + qcol + hi * 8;
#pragma unroll
        for (int d0 = 0; d0 < 4; ++d0) qf[d0] = *(const bf16x8*)(qp + d0 * 16); }
    const int kvr = lane, pc = wv;
    const int vpos = (kvr & 48) | ((kvr & 3) + 4 * ((kvr >> 3) & 1) + 8 * ((kvr >> 2) & 1));
    const int bi0 = -qi + 4 * hi, bsf = bi0 & 3;
    const LAS float* btab = biasT + bsf * 392 + (bi0 - bsf + 64);
    f32x4 rk0A, rk1A, rv0A, rv1A, rk0B, rk1B, rv0B, rv1B;
    auto tile_f32 = [&](int j) __attribute__((always_inline)) { return (mode == AT_SB && j < 8) || mode == AT_SM; };
    auto load_tile = [&](int j, auto par_) __attribute__((always_inline)) { constexpr int P = decltype(par_)::value;
        const void* kp; const void* vp; bool f32s = false;
        if (mode == AT_PB) { const bf16_t* p = KVb + (size_t)(b * TP + (c0 - 8 + j) * 64 + kvr) * 1536 + h * 64 + pc * 8; kp = p; vp = p + AW; }
        else if (mode == AT_SB) {
            if (j < 8) { const size_t o = ((size_t)(b * 512 + j * 64 + kvr) * 12 + h) * 64 + pc * 8; kp = a.in[4] + o; vp = a.in[5] + o; f32s = true; }
            else { const bf16_t* p = KVb + (size_t)(NP + b * TS + kvr) * 1536 + h * 64 + pc * 8; kp = p; vp = p + AW; } }
        else if (mode == AT_PM) { const bf16_t* p = MKV + (size_t)(b * 256 + j * 64 + kvr) * 1024 + layer * 512 + h * 64 + pc * 8; kp = p; vp = p + 256; }
        else { const size_t o = (((size_t)(layer * BS + b) * 256 + j * 64 + kvr) * 4 + h) * 64 + pc * 8; kp = a.in[6] + o; vp = a.in[7] + o; f32s = true; }
        f32x4& rk0 = P ? rk0B : rk0A; f32x4& rk1 = P ? rk1B : rk1A; f32x4& rv0 = P ? rv0B : rv0A; f32x4& rv1 = P ? rv1B : rv1A;
        rk0 = ((const f32x4*)kp)[0]; rv0 = ((const f32x4*)vp)[0];
        if (f32s) { rk1 = ((const f32x4*)kp)[1]; rv1 = ((const f32x4*)vp)[1]; }
    };
    float m = -1e30f, l = 0.f; f32x16 o0, o1;
#pragma unroll
    for (int r = 0; r < 16; ++r) { o0[r] = 0.f; o1[r] = 0.f; }
    load_tile(j0, IC0{}); if (j0 < j1) load_tile(j0 + 1, IC1{});
    auto step = [&](int j, auto par_) __attribute__((always_inline)) { constexpr int P = decltype(par_)::value;
        const bool rawf32 = tile_f32(j);
        LAS unsigned char* Ks = lds + P * 18432; LAS bf16_t* Vt = (LAS bf16_t*)(Ks + 9216);
        { u32x4 kb, vb;
          const f32x4 rk0 = P ? rk0B : rk0A, rk1 = P ? rk1B : rk1A, rv0 = P ? rv0B : rv0A, rv1 = P ? rv1B : rv1A;
          if (rawf32) { kb = pack8(rk0, rk1); vb = pack8(rv0, rv1); } else { kb = __builtin_bit_cast(u32x4, rk0); vb = __builtin_bit_cast(u32x4, rv0); }
          *(LAS u32x4*)(Ks + kvr * 144 + pc * 16) = kb;
          LAS bf16_t* vd = Vt + (pc * 8) * 72 + vpos;
          vd[0 * 72] = (bf16_t)(vb.x & 0xffffu); vd[1 * 72] = (bf16_t)(vb.x >> 16); vd[2 * 72] = (bf16_t)(vb.y & 0xffffu); vd[3 * 72] = (bf16_t)(vb.y >> 16);
          vd[4 * 72] = (bf16_t)(vb.z & 0xffffu); vd[5 * 72] = (bf16_t)(vb.z >> 16); vd[6 * 72] = (bf16_t)(vb.w & 0xffffu); vd[7 * 72] = (bf16_t)(vb.w >> 16); }
        asm volatile("s_waitcnt lgkmcnt(0)\n\ts_barrier" ::: "memory");
        if (j + 2 <= j1) load_tile(j + 2, par_);
        const int jrel = j - wofs;
        if (active && jrel >= 0 && (!band || jrel <= 8)) {
            f32x16 p0, p1;
#pragma unroll
            for (int r = 0; r < 16; ++r) { p0[r] = 0.f; p1[r] = 0.f; }
            const LAS unsigned char* kp = Ks + q * 144 + hi * 16;
#pragma unroll
            for (int d0 = 0; d0 < 4; ++d0) { const bf16x8 k0 = *(const LAS bf16x8*)(kp + d0 * 32), k1 = *(const LAS bf16x8*)(kp + 32 * 144 + d0 * 32);
                p0 = __builtin_amdgcn_mfma_f32_32x32x16_bf16(k0, qf[d0], p0, 0, 0, 0); p1 = __builtin_amdgcn_mfma_f32_32x32x16_bf16(k1, qf[d0], p1, 0, 0, 0); }
            const float C = 0.125f * LOG2E;
            if (band) {
                if (jrel <= 3) { const float bc = biasT[0];
                    p0 += bc; p1 += bc; }
                else { const LAS float* bt = btab + (jrel - 4) * 64;
#pragma unroll
                    for (int g = 0; g < 4; ++g) { const f32x4 b0 = *(const LAS f32x4*)(bt + 8 * g), b1 = *(const LAS f32x4*)(bt + 8 * g + 32);
#pragma unroll
                        for (int c = 0; c < 4; ++c) { p0[4 * g + c] += b0[c]; p1[4 * g + c] += b1[c]; } } }
            }
            float mx = fmaxf(p0[0], p1[0]);
#pragma unroll
            for (int r = 1; r < 16; ++r) mx = fmaxf(mx, fmaxf(p0[r], p1[r]));
            mx = fmaxf(mx, __shfl_xor(mx, 32));
            if (__any(mx > m + 44.0f)) {
                const float mn = fmaxf(m, mx), sc = __builtin_amdgcn_exp2f((m - mn) * C); m = mn; l *= sc;
#pragma unroll
                for (int r = 0; r < 16; ++r) { o0[r] *= sc; o1[r] *= sc; }
            }
            const float nmc = -m * C;
            p0 = p0 * C + nmc; p1 = p1 * C + nmc;
#pragma unroll
            for (int r = 0; r < 16; ++r) { p0[r] = __builtin_amdgcn_exp2f(p0[r]); p1[r] = __builtin_amdgcn_exp2f(p1[r]); }
            { const f32x16 sv = p0 + p1;
              const f32x4 s4 = (f32x4){sv[0], sv[1], sv[2], sv[3]} + (f32x4){sv[4], sv[5], sv[6], sv[7]} + (f32x4){sv[8], sv[9], sv[10], sv[11]} + (f32x4){sv[12], sv[13], sv[14], sv[15]};
              l += (s4[0] + s4[1]) + (s4[2] + s4[3]); }
            bf16x8 pw[4];
            { u32x4 t; t.x = cvt_pk_bf16(p0[0], p0[1]); t.y = cvt_pk_bf16(p0[2], p0[3]); t.z = cvt_pk_bf16(p0[4], p0[5]); t.w = cvt_pk_bf16(p0[6], p0[7]); pw[0] = __builtin_bit_cast(bf16x8, t);
              t.x = cvt_pk_bf16(p0[8], p0[9]); t.y = cvt_pk_bf16(p0[10], p0[11]); t.z = cvt_pk_bf16(p0[12], p0[13]); t.w = cvt_pk_bf16(p0[14], p0[15]); pw[1] = __builtin_bit_cast(bf16x8, t);
              t.x = cvt_pk_bf16(p1[0], p1[1]); t.y = cvt_pk_bf16(p1[2], p1[3]); t.z = cvt_pk_bf16(p1[4], p1[5]); t.w = cvt_pk_bf16(p1[6], p1[7]); pw[2] = __builtin_bit_cast(bf16x8, t);
              t.x = cvt_pk_bf16(p1[8], p1[9]); t.y = cvt_pk_bf16(p1[10], p1[11]); t.z = cvt_pk_bf16(p1[12], p1[13]); t.w = cvt_pk_bf16(p1[14], p1[15]); pw[3] = __builtin_bit_cast(bf16x8, t); }
#pragma unroll
            for (int k = 0; k < 4; ++k) {
                const LAS bf16_t* v0p = Vt + q * 72 + k * 16 + 8 * hi;
                const bf16x8 vf0 = *(const LAS bf16x8*)v0p, vf1 = *(const LAS bf16x8*)(v0p + 32 * 72);
                o0 = __builtin_amdgcn_mfma_f32_32x32x16_bf16(vf0, pw[k], o0, 0, 0, 0); o1 = __builtin_amdgcn_mfma_f32_32x32x16_bf16(vf1, pw[k], o1, 0, 0, 0);
            }
        }
    };
    for (int j = j0; j <= j1; j += 2) { step(j, IC0{}); if (j < j1) step(j + 1, IC1{}); }
    if (active) {
        l += __shfl_xor(l, 32); const float inv = 1.0f / l;
        bf16_t* op = MIX + (size_t)(row0 + wv * 32 + q) * DM + ocol + 4 * hi;
#pragma unroll
        for (int g = 0; g < 4; ++g) {
            u32x2 w0, w1; w0.x = cvt_pk_bf16(o0[4 * g] * inv, o0[4 * g + 1] * inv); w0.y = cvt_pk_bf16(o0[4 * g + 2] * inv, o0[4 * g + 3] * inv);
            w1.x = cvt_pk_bf16(o1[4 * g] * inv, o1[4 * g + 1] * inv); w1.y = cvt_pk_bf16(o1[4 * g + 2] * inv, o1[4 * g + 3] * inv);
            *(u32x2*)(op + 8 * g) = w0; *(u32x2*)(op + 32 + 8 * g) = w1; }
    }
}

#define XB_TMO      128
#define XB_XCNT(j)  (256  + 64 * (j))
#define XB_XSUB(j)  (1280 + 64 * (j))
#define XB_XGEN(j)  (2304 + 64 * (j))
#define XB_TOP      3328
#define XB_TOPGEN   3392
#define XCD_BAR_WORDS 3456
#define XB_SPIN_CAP (1u << 18)

__device__ __forceinline__ unsigned xb_ld(unsigned* p)              { return __hip_atomic_load(p, __ATOMIC_RELAXED, __HIP_MEMORY_SCOPE_AGENT); }
__device__ __forceinline__ unsigned xb_add(unsigned* p, unsigned v) { return __hip_atomic_fetch_add(p, v, __ATOMIC_RELAXED, __HIP_MEMORY_SCOPE_AGENT); }
__device__ __forceinline__ unsigned xb_xcc_id() { return (unsigned)__builtin_amdgcn_s_getreg((3 << 11) | 20) & 0xFu; }
#define XB_SPIN(cond, bar) do { unsigned _sp = 0; while (cond) { __builtin_amdgcn_s_sleep(1); \
    if ((++_sp & 255u) == 0u) { if (xb_ld(&(bar)[XB_TMO])) break; if (_sp > XB_SPIN_CAP) { atomicAdd(&(bar)[XB_TMO], 1u); break; } } } } while (0)

struct XcdBarrier {
    unsigned* bar; unsigned x;
    volatile LAS unsigned* st;
};

__device__ __forceinline__ XcdBarrier xcd_barrier_post(unsigned* bar, volatile LAS unsigned* st) {
    XcdBarrier b; b.bar = bar; b.x = xb_xcc_id(); b.st = st;
    if (threadIdx.x == 0) (void)xb_add(&bar[XB_XCNT(b.x)], 1u);
    return b;
}
__device__ __forceinline__ void xcd_barrier_complete(unsigned* bar, unsigned x, unsigned& nloc, unsigned& nx) {
    const unsigned G = gridDim.x * gridDim.y * gridDim.z;
    unsigned sum, cnt, mine, sp = 0u;
    for (;;) {
        sum = 0u; cnt = 0u; mine = 0u;
#pragma unroll
        for (unsigned j = 0; j < 16; ++j) { const unsigned c = xb_ld(&bar[XB_XCNT(j)]); sum += c; cnt += (c > 0u) ? 1u : 0u; mine = (j == x) ? c : mine; }
        if (sum == G) break;
        __builtin_amdgcn_s_sleep(1);
        if ((++sp & 255u) == 0u) { if (xb_ld(&bar[XB_TMO])) break; if (sp > XB_SPIN_CAP) { atomicAdd(&bar[XB_TMO], 1u); break; } }
    }
    nloc = mine > 0u ? mine : 1u; nx = cnt > 0u ? cnt : 1u;
}

__device__ __forceinline__ void xcd_barrier(const XcdBarrier& b) {
    asm volatile("s_waitcnt vmcnt(0)" ::: "memory");
    __syncthreads();
    if (threadIdx.x == 0) {
        unsigned* bar = b.bar;
        __builtin_amdgcn_s_waitcnt(0);
        unsigned nloc = b.st[0], nx = b.st[1];
        if (nloc == 0u) { xcd_barrier_complete(bar, b.x, nloc, nx); b.st[0] = nloc; b.st[1] = nx; }
        const unsigned old = xb_add(&bar[XB_XSUB(b.x)], 1u);
        const unsigned gen = old / nloc;
        if (old + 1u == (gen + 1u) * nloc) {
            __builtin_amdgcn_fence(__ATOMIC_RELEASE, "agent");
            asm volatile("s_waitcnt vmcnt(0)" ::: "memory");
            const unsigned og = xb_add(&bar[XB_TOP], 1u);
            const unsigned tg = og / nx;
            if (og + 1u == (tg + 1u) * nx) xb_add(&bar[XB_TOPGEN], 1u);
            else XB_SPIN(xb_ld(&bar[XB_TOPGEN]) == tg, bar);
            __builtin_amdgcn_fence(__ATOMIC_ACQUIRE, "agent");
            xb_add(&bar[XB_XGEN(b.x)], 1u);
            asm volatile("s_waitcnt vmcnt(0)" ::: "memory");
        } else {
            XB_SPIN(xb_ld(&bar[XB_XGEN(b.x)]) == gen, bar);
            __builtin_amdgcn_fence(__ATOMIC_ACQUIRE, "agent");
            asm volatile("s_waitcnt vmcnt(0)" ::: "memory");
        }
    }
    __syncthreads();
}

constexpr int NPHASE = 16;
__global__ void __launch_bounds__(512, 2) yoco_fwd(Args a) {
    extern __shared__ __attribute__((aligned(16))) unsigned char lds_raw[];
    LAS unsigned char* lds = (LAS unsigned char*)lds_raw;
    cg::grid_group grid = cg::this_grid();
    const int tid = threadIdx.x, lane = tid & 63, wave = __builtin_amdgcn_readfirstlane(tid >> 6);
    const int G = gridDim.x, gw = blockIdx.x * 8 + wave, NGW = G * 8;
    unsigned char* ws = a.ws; float* out = a.out;
    bf16_t* WINA = (bf16_t*)(ws + WS_WINA); bf16_t* WKVB = (bf16_t*)(ws + WS_WKVB); bf16_t* WMEM = (bf16_t*)(ws + WS_WMEM); bf16_t* WOUT = (bf16_t*)(ws + WS_WOUT);
    bf16_t* WGU = (bf16_t*)(ws + WS_WGU); bf16_t* WDN = (bf16_t*)(ws + WS_WDN); bf16_t* WGT = (bf16_t*)(ws + WS_WG);
    bf16_t* MN = (bf16_t*)(ws + WS_MN); bf16_t* MKV = (bf16_t*)(ws + WS_MKV); bf16_t* XN = (bf16_t*)(ws + WS_XN); bf16_t* KVb = (bf16_t*)(ws + WS_KV);
    bf16_t* HB = (bf16_t*)(ws + WS_H); bf16_t* PROJ = (bf16_t*)(ws + WS_PROJ); bf16_t* MIX = (bf16_t*)(ws + WS_MIX);
    float* X = out + O_Y; float* SS = (float*)(ws + WS_SS); bf16_t* PART = (bf16_t*)(ws + WS_PART);
    const int lo = a.ph_lo, hi = a.ph_hi;
    volatile LAS unsigned* MISC = (volatile LAS unsigned*)(lds + 131072 + 512);
    if (tid < 2) MISC[tid] = 0u;
    __syncthreads();
    XcdBarrier bar; bar.bar = (unsigned*)(ws + WS_BAR); bar.x = 0; bar.st = MISC;
    if (hi - lo > 1) bar = xcd_barrier_post((unsigned*)(ws + WS_BAR), MISC);
    if (hi - lo > 1) grid.sync();
#if DUP_MASK
    const float esc = (a.flags & 1) ? 0.f : 1.f;
#else
    constexpr float esc = 1.f;
#endif
#define IN(k) (lo <= (k) && (k) < hi)
#define SEAM(k) do { if (IN(k) && IN((k) + 1)) { xcd_barrier(bar); } } while (0)

    if (IN(0)) {
        LAS float* scr = (LAS float*)(lds + wave * 16384);
        for (int it = gw; it < W_EARLY; it += NGW) weight_item(a, it, scr, lane);
        for (int e = blockIdx.x * 512 + tid; e < 2 * 12 * 4096; e += G * 512) {
            const int gsel = e / (12 * 4096), rem = e % (12 * 4096), n = rem >> 12, j = (rem >> 6) & 63, i = rem & 63;
            WGT[e] = (bf16_t)f2bf(-LOG2E * a.in[gsel ? 17 : 15][(size_t)n * 4096 + i * 64 + j]);
        }
        for (int e = blockIdx.x * 512 + tid; e < 3 * MT; e += G * 512) SS[e] = 0.f;
        { unsigned long long* CAR = (unsigned long long*)(ws + WS_CAR); for (int e = blockIdx.x * 512 + tid; e < 256 * LW; e += G * 512) CAR[e] = ~0ull; }
        for (int mrow = gw * 2; mrow < MT + NMEMR; mrow += NGW * 2) {
            const float* src; bf16_t* dst; float* ssp = SS + 3 * MT + mrow;
            if (mrow < NP) { src = a.in[0] + (size_t)mrow * DM; dst = XN + (size_t)mrow * DM; }
            else if (mrow < MT) { src = a.in[1] + (size_t)(mrow - NP) * DM; dst = XN + (size_t)mrow * DM; }
            else { src = a.in[8] + (size_t)(mrow - MT) * DM; dst = MN + (size_t)(mrow - MT) * DM; ssp = nullptr; }
            norm_row2_bf16(src, dst, ssp, lane);
        }
    }
    SEAM(0);
    if (IN(1)) {
        { EpiMemKV E{MKV, out}; run_gemm(lds, MN, WMEM, NMEMR, 1024, 1024, E); }
        { EpiBf16Plain E{PROJ, NINA, nullptr}; run_gemm_ss(lds, XN, WINA, MT, NINA, 1024, E, SS + 3 * MT); }
        {
            const int c0 = G > 64 ? 32 : 0, nw = (G - c0) * 8; LAS float* scr = (LAS float*)(lds + wave * 16384);
            if ((int)blockIdx.x >= c0) for (int q = ((int)blockIdx.x - c0) * 8 + wave; q < W_P1; q += nw) weight_item(a, witem_p1(q), scr, lane);
        }
    }
    SEAM(1);
    if (IN(2)) {
        for (int it = gw; it < 288 * 12; it += NGW) scan_onepass(a, it / 12, it % 12, lds + wave * 16384, lane);
        __syncthreads();
        for (int it = blockIdx.x; it < 256; it += G) attn_item(a, lds, AT_PM, it, 0);
        { const int b0 = G >= 256 ? 176 : 0; if ((int)blockIdx.x >= b0) for (int it = (int)blockIdx.x - b0; it < 128; it += G - b0) attn_item(a, lds, AT_SM, it, 0); }
    }
    SEAM(2);
    if (IN(4)) { EpiResid E{nullptr, XN, nullptr, XN, SS, PART, esc}; run_gemm_resid(lds, MIX, WOUT, 1024, E); }
    SEAM(4);
    if (IN(5)) { for (int sr = gw; sr < NS; sr += NGW) reduce_row(nullptr, XN + (size_t)(NP + sr) * DM, PART, sr, XN + (size_t)(NP + sr) * DM, SS + NP + sr, lane); }
    SEAM(5);
    if (IN(6)) { EpiSwiGLU E{HB, nullptr}; run_gemm_ss(lds, XN, WGU, MT, 2 * DFF, 1024, E, SS);
        {
            const int c0 = G > 96 ? 48 : 0, nw = (G - c0) * 8; LAS float* scr = (LAS float*)(lds + wave * 16384);
            if ((int)blockIdx.x >= c0) for (int q = ((int)blockIdx.x - c0) * 8 + wave; q < W_P6; q += nw) weight_item(a, witem_p6(q), scr, lane);
        } }
    SEAM(6);
    if (IN(7)) { EpiResid E{nullptr, XN, nullptr, XN, SS + MT, PART, esc}; run_gemm_resid(lds, HB, WDN, DFF, E); }
    SEAM(7);
    if (IN(8)) { for (int sr = gw; sr < NS; sr += NGW) reduce_row(nullptr, XN + (size_t)(NP + sr) * DM, PART, sr, XN + (size_t)(NP + sr) * DM, SS + MT + NP + sr, lane); }
    SEAM(8);
    if (IN(9)) { EpiKVQ E{KVb, PROJ, out, nullptr}; run_gemm_ss(lds, XN, WKVB, MT, NKVQ, 1024, E, SS + MT); }
    SEAM(9);
    if (IN(10)) {
        __syncthreads(); attn_bias_tables(a, lds);
        for (int it = blockIdx.x; it < 768 + 256 + 384 + 128; it += G) {
            if (it < 768) attn_item(a, lds, AT_PB, it, 1);
            else if (it < 1024) attn_item(a, lds, AT_PM, it - 768, 1);
            else if (it < 1408) attn_item(a, lds, AT_SB, it - 1024, 1);
            else attn_item(a, lds, AT_SM, it - 1408, 1);
        }
    }
    SEAM(10);
    if (IN(11)) { EpiResid E{nullptr, XN, nullptr, XN, SS + 2 * MT, PART, esc}; run_gemm_resid(lds, MIX, WOUT + (size_t)1024 * 1024, 1024, E); }
    SEAM(11);
    if (IN(12)) { for (int sr = gw; sr < NS; sr += NGW) reduce_row(nullptr, XN + (size_t)(NP + sr) * DM, PART, sr, XN + (size_t)(NP + sr) * DM, SS + 2 * MT + NP + sr, lane); }
    SEAM(12);
    if (IN(13)) { EpiSwiGLU E{HB, nullptr}; run_gemm_ss(lds, XN, WGU + (size_t)2 * DFF * 1024, MT, 2 * DFF, 1024, E, SS + 2 * MT); }
    SEAM(13);
    if (IN(14)) { EpiResid E{nullptr, XN, nullptr, XN, nullptr, PART, esc}; run_gemm_resid(lds, HB, WDN + (size_t)1024 * DFF, DFF, E); }
    SEAM(14);
    if (IN(15)) {
        for (int mrow = gw * 2; mrow < NP; mrow += NGW * 2) norm_row2_final_h(XN + (size_t)mrow * DM, X + (size_t)mrow * DM, a.in[11], lane);
        for (int mrow = NP + gw; mrow < MT; mrow += NGW) {
            { f32x4 v[4]; float* xr = X + (size_t)mrow * DM; const float rstd = rstd_of(reduce_row_regs(nullptr, XN + (size_t)mrow * DM, PART, mrow - NP, lane, v));
#pragma unroll
                for (int j = 0; j < 4; ++j) ((f32x4*)xr)[lane + 64 * j] = v[j] * rstd * ((const f32x4*)a.in[11])[lane + 64 * j]; }
        }
    }
#undef IN
#undef SEAM
}

extern "C" void kernel_launch(void* const* d_in, const int* in_sizes, int n_in, void* d_out, int out_size, void* d_ws, size_t ws_size, hipStream_t stream) {
    static int grid = 0;
    if (grid == 0) {
        if (n_in != 29 || (size_t)out_size != O_END || ws_size < WS_END) { fprintf(stderr, "kernel_launch: unexpected shapes: n_in %d out %d ws %zu\n", n_in, out_size, ws_size); grid = -1; return; }
        int dev = 0, cus = 0, per_cu = 0;
        hipGetDevice(&dev); hipDeviceGetAttribute(&cus, hipDeviceAttributeMultiprocessorCount, dev);
        if (hipFuncSetAttribute((const void*)yoco_fwd, hipFuncAttributeMaxDynamicSharedMemorySize, LDS_BYTES) != hipSuccess) { fprintf(stderr, "kernel_launch: hipFuncSetAttribute failed\n"); grid = -1; return; }
        if (hipOccupancyMaxActiveBlocksPerMultiprocessor(&per_cu, (const void*)yoco_fwd, 512, LDS_BYTES) != hipSuccess || per_cu < 1) { fprintf(stderr, "kernel_launch: occupancy query says %d\n", per_cu); per_cu = 1; }
        (void)hipGetLastError();
        grid = cus;
        fprintf(stderr, "kernel_launch: grid %d (per_cu %d)\n", grid, per_cu);
    }
    if (grid < 0) return;
    Args a{};
    for (int i = 0; i < 29; ++i) a.in[i] = (const float*)d_in[i];
    a.out = (float*)d_out; a.ws = (unsigned char*)d_ws;
#if MK_N_LAUNCHES == 1
    if (hipMemsetAsync((char*)d_ws + WS_BAR, 0, 16384, stream) != hipSuccess) { fprintf(stderr, "kernel_launch: memset of barrier words failed\n"); return; }
    a.ph_lo = 0; a.ph_hi = NPHASE;
    void* args[] = {&a};
    hipError_t e = hipLaunchCooperativeKernel((const void*)yoco_fwd, dim3(grid), dim3(512), args, LDS_BYTES, stream);
    if (e != hipSuccess) fprintf(stderr, "cooperative launch failed: %s (grid %d)\n", hipGetErrorString(e), grid);
#else
    for (int p = 0; p < NPHASE; ++p) for (int rep = ((DUP_MASK >> p) & 1) ? 0 : 1; rep < 2; ++rep) { a.ph_lo = p; a.ph_hi = p + 1; a.flags = rep == 0 ? 1 : 0; hipLaunchKernelGGL(yoco_fwd, dim3(grid), dim3(512), LDS_BYTES, stream, a); }
#endif
}
```

```cpp
#include <hip/hip_runtime.h>
#include <hip/hip_cooperative_groups.h>
#include <cstdio>
#include <cstdint>
namespace cg = cooperative_groups;
namespace pg8 {
#define PG8_LAS __attribute__((address_space(3)))
typedef unsigned short bf16_t;
typedef short bf16x8 __attribute__((ext_vector_type(8)));
typedef float f32x4 __attribute__((ext_vector_type(4)));
typedef unsigned u32x4 __attribute__((ext_vector_type(4)));
constexpr int BM = 256, BK = 64, HALF = 128, HTB = HALF * BK * 2  , STAGE_BYTES = 8 * HTB, NXCD = 8, WGM = 8;

__host__ __device__ __forceinline__ int lds_byte(int r, int c) { const int st = (r >> 4) * 2 + (c >> 5), rr = r & 15, cc = c & 31, ob = rr * 64 + cc * 2; return st * 1024 + (ob ^ (((ob >> 9) & 1) << 5)); }
__host__ __device__ __forceinline__ void stage_rc(int b, int& R, int& C) { const int st = b / 1024, sb = b % 1024, swz = sb ^ (((sb >> 9) & 1) << 5); R = (st >> 1) * 16 + swz / 64; C = (st & 1) * 32 + (swz % 64) / 2; }
__host__ __device__ __forceinline__ int perm32(int rho) { const int n = rho >> 4, i = rho & 15; return 8 * (i >> 2) + 4 * n + (i & 3); }

struct Unit { int pm, pn, k0, nt, sp; };
struct Gemm { const bf16_t* A; const bf16_t* Bt; int M, N, K; };

struct StaticOrder {
    int nM, nN, nwg, G, c, ntf; const float* ssrc = nullptr; mutable float pre[8];
    __host__ __device__ __forceinline__ void init(int M, int N, int K, int G_, int c_) { nM = M / BM; nN = N / BM; nwg = nM * nN; G = G_; c = c_; ntf = K / BK; }
    __host__ __device__ __forceinline__ bool next(int i, Unit& u) const {
        const long L = (long)i * G + c; if (L >= nwg) return false;
        int wgid = (int)L; { const int q = nwg / NXCD, r = nwg % NXCD, xcd = wgid % NXCD, off = wgid / NXCD; wgid = (xcd < r ? xcd * (q + 1) : r * (q + 1) + (xcd - r) * q) + off; }
        const int nig = WGM * nN, gid = wgid / nig, fm = gid * WGM, gsz = (nM - fm) < WGM ? (nM - fm) : WGM;
        u.pm = fm + ((wgid % nig) % gsz); u.pn = (wgid % nig) / gsz; u.k0 = 0; u.nt = ntf; u.sp = 0; return true;
    }
    __host__ __device__ __forceinline__ Unit get(int i) const {
        const long L = (long)i * G + c; const bool ok = L < nwg;
        int wgid = ok ? (int)L : 0; { const int q = nwg / NXCD, r = nwg % NXCD, xcd = wgid % NXCD, off = wgid / NXCD; wgid = (xcd < r ? xcd * (q + 1) : r * (q + 1) + (xcd - r) * q) + off; }
        const int nig = WGM * nN, gid = wgid / nig, fm = gid * WGM, gsz = (nM - fm) < WGM ? (nM - fm) : WGM;
        Unit u; u.pm = ok ? fm + ((wgid % nig) % gsz) : -1; u.pn = (wgid % nig) / gsz; u.k0 = 0; u.nt = ntf; u.sp = 0; return u;
    }
    __device__ __forceinline__ void prefetch(const Unit& u, int wr, int fr) const {
        if (ssrc) { _Pragma("unroll") for (int ai = 0; ai < 2; ++ai) _Pragma("unroll") for (int m = 0; m < 4; ++m) pre[ai * 4 + m] = ssrc[u.pm * BM + ai * HALF + wr * 64 + m * 16 + fr]; } }
    __device__ __forceinline__ void a_ready(const Unit&) const {}
    __device__ __forceinline__ void done(const Unit&) const {}
};

struct ResidOrder {
    StaticOrder S0; int G, c, ntf;
    __host__ __device__ __forceinline__ void init(int K, int G_, int c_) { S0.init(16384, 1024, K, G_, c_); G = G_; c = c_; ntf = K / BK; }
    __host__ __device__ __forceinline__ bool next(int i, Unit& u) const {
        const long L = (long)i * G + c; if (L < 256) return S0.next(i, u);
        const int L2 = (int)(L - 256); if (L2 >= 256) return false;
        const int su = L2 >> 3, sp = L2 & 7, base = (ntf / 8) & ~1, rem2 = (ntf - 8 * base) / 2;
        u.pm = 64 + (su >> 2); u.pn = su & 3; u.sp = sp; u.nt = base + (sp < rem2 ? 2 : 0); u.k0 = sp * base + 2 * (sp < rem2 ? sp : rem2); return true;
    }
    __host__ __device__ __forceinline__ Unit get(int i) const {
        const long L = (long)i * G + c; const Unit u0 = S0.get(i);
        const int L2 = (int)(L - 256); const bool tail = L >= 256, ok = L2 < 256;
        const int su = (L2 >> 3) & 31, sp = L2 & 7, base = (ntf / 8) & ~1, rem2 = (ntf - 8 * base) / 2;
        Unit u; u.pm = tail ? (ok ? 64 + (su >> 2) : -1) : u0.pm; u.pn = tail ? (su & 3) : u0.pn; u.sp = tail ? sp : 0;
        u.nt = tail ? base + (sp < rem2 ? 2 : 0) : ntf; u.k0 = tail ? sp * base + 2 * (sp < rem2 ? sp : rem2) : 0; return u;
    }
    __device__ __forceinline__ void prefetch(const Unit&, int, int) const {}
    __device__ __forceinline__ void a_ready(const Unit&) const {}
    __device__ __forceinline__ void done(const Unit&) const {}
};

typedef float f32x2c_t __attribute__((ext_vector_type(2))); typedef __bf16 bf16x2c_t __attribute__((ext_vector_type(2)));
__device__ __forceinline__ unsigned cvt_pk_bf16(float lo, float hi) { f32x2c_t v = {lo, hi}; bf16x2c_t b = __builtin_convertvector(v, bf16x2c_t); return __builtin_bit_cast(unsigned, b); }
typedef float f32x2 __attribute__((ext_vector_type(2)));
template <class Epi, class Sched, bool ALIGN_EPI = false, bool SP2 = false>
__device__ __forceinline__ void gemm_phase(PG8_LAS unsigned char* lds, const Gemm g, const Sched& S, const Epi& E) {
    const int tid = threadIdx.x, wid = __builtin_amdgcn_readfirstlane(tid >> 6), lane = tid & 63, wr = wid >> 2, wc = wid & 3, fr = lane & 15, fq = lane >> 4;
    const int K = g.K;
    unsigned voffA[2], voffB[2];
#pragma unroll
    for (int i = 0; i < 2; ++i) { int R, C; stage_rc(tid * 16 + i * 8192, R, C); const int Rb = Epi::PERM ? ((R & ~31) + perm32(R & 31)) : R;
        voffA[i] = (unsigned)(R * K + C) * 2u; voffB[i] = (unsigned)(Rb * K + C) * 2u; }
    const size_t kstep = (size_t)(BK * 2);
    const size_t hstep = (size_t)HALF * K * 2;
    const size_t tstep = 2 * hstep;
    const unsigned ldsw = (unsigned)wid * 1024u;
    const int aoff = lds_byte(wr * 64 + fr, fq * 8), boff = lds_byte(wc * 32 + fr, fq * 8);
#define PG8_SA(b, h) (((b) * 2 + (h)) * HTB)
#define PG8_SB(b, h) ((4 + (b) * 2 + (h)) * HTB)
#define PG8_STAGE(bufoff, gbase, voff) do { _Pragma("unroll") for (int _i = 0; _i < 2; ++_i) \
        __builtin_amdgcn_global_load_lds((const unsigned*)((const char*)(gbase) + (voff)[_i]), (PG8_LAS unsigned*)(lds + (bufoff) + ldsw + _i * 8192), 16, 0, 0); } while (0)
#define PG8_LDA(dst, b, h) do { _Pragma("unroll") for (int m = 0; m < 4; ++m) _Pragma("unroll") for (int k = 0; k < 2; ++k) dst[m][k] = *(const PG8_LAS bf16x8*)(lds + PG8_SA(b, h) + aoff + m * 2048 + k * 1024); } while (0)
#define PG8_LDB(dst, b, h) do { _Pragma("unroll") for (int n = 0; n < 2; ++n) _Pragma("unroll") for (int k = 0; k < 2; ++k) dst[n][k] = *(const PG8_LAS bf16x8*)(lds + PG8_SB(b, h) + boff + n * 2048 + k * 1024); } while (0)
#define PG8_MMA(ai, bj, At, Bt) do { __builtin_amdgcn_s_setprio(1); _Pragma("unroll") for (int m = 0; m < 4; ++m) _Pragma("unroll") for (int n = 0; n < 2; ++n) _Pragma("unroll") for (int k = 0; k < 2; ++k) \
        acc[ai][bj][m][n] = __builtin_amdgcn_mfma_f32_16x16x32_bf16(Bt[n][k], At[m][k], acc[ai][bj][m][n], 0, 0, 0); __builtin_amdgcn_s_setprio(0); } while (0)
#define PG8_WAIT_V(n) asm volatile("s_waitcnt vmcnt(" #n ")" ::: "memory")
#define PG8_WAIT_L(n) asm volatile("s_waitcnt lgkmcnt(" #n ")" ::: "memory")
#define PG8_BAR __builtin_amdgcn_s_barrier()
#define PG8_SCHED __builtin_amdgcn_sched_barrier(0)
    Unit cur, nxt; int ui = 0;
    cur = S.get(0); if (cur.pm < 0) return;
    f32x4 acc[2][2][4][2];
#pragma unroll
    for (int a = 0; a < 2; ++a)
#pragma unroll
        for (int b = 0; b < 2; ++b)
#pragma unroll
            for (int m = 0; m < 4; ++m)
#pragma unroll
                for (int n = 0; n < 2; ++n) acc[a][b][m][n] = (f32x4){0.f, 0.f, 0.f, 0.f};
    bf16x8 At[4][2], B0[2][2], B1[2][2];
    const char* cA = (const char*)g.A + (size_t)cur.pm * tstep + (size_t)cur.k0 * kstep; const char* cB = (const char*)g.Bt + (size_t)cur.pn * tstep + (size_t)cur.k0 * kstep;
    int nt = cur.nt;
    S.a_ready(cur); S.prefetch(cur, wr, fr);
    if constexpr (SP2) {
        PG8_STAGE(PG8_SB(0, 0), cB, voffB); PG8_STAGE(PG8_SB(0, 1), cB + hstep, voffB); PG8_STAGE(PG8_SA(0, 0), cA, voffA); PG8_STAGE(PG8_SA(0, 1), cA + hstep, voffA);
        if (wr == 1) PG8_BAR;
        PG8_WAIT_V(2); PG8_BAR;
        PG8_STAGE(PG8_SB(1, 0), cB + kstep, voffB); PG8_STAGE(PG8_SA(1, 0), cA + kstep, voffA); PG8_STAGE(PG8_SB(1, 1), cB + hstep + kstep, voffB);
        PG8_WAIT_V(6); PG8_BAR;
    } else {
        PG8_STAGE(PG8_SB(0, 0), cB, voffB); PG8_STAGE(PG8_SA(0, 0), cA, voffA); PG8_STAGE(PG8_SB(0, 1), cB + hstep, voffB); PG8_STAGE(PG8_SA(0, 1), cA + hstep, voffA);
        if (wr == 1) PG8_BAR;
        PG8_WAIT_V(4); PG8_BAR;
        PG8_STAGE(PG8_SB(1, 0), cB + kstep, voffB); PG8_STAGE(PG8_SA(1, 0), cA + kstep, voffA); PG8_STAGE(PG8_SB(1, 1), cB + hstep + kstep, voffB);
        PG8_WAIT_V(6); PG8_BAR;
    }
    for (;;) {
        nxt = S.get(ui + 1); const bool has_next = nxt.pm >= 0;
        const char* nA = has_next ? (const char*)g.A + (size_t)nxt.pm * tstep + (size_t)nxt.k0 * kstep : cA; const char* nB = has_next ? (const char*)g.Bt + (size_t)nxt.pn * tstep + (size_t)nxt.k0 * kstep : cB;
        for (int t = 0; t < nt; t += 2) {
            const bool last = (t == nt - 2);
            const char* a1 = cA + (size_t)(t + 1) * kstep;
            const char* a2 = last ? nA : cA + (size_t)(t + 2) * kstep; const char* b2 = last ? nB : cB + (size_t)(t + 2) * kstep;
            const char* a3 = a2 + kstep; const char* b3 = b2 + kstep;
            if (last && has_next) S.a_ready(nxt);
            if constexpr (SP2) {
            PG8_LDB(B0, 0, 0); PG8_LDB(B1, 0, 1); PG8_SCHED; PG8_LDA(At, 0, 0); PG8_STAGE(PG8_SA(1, 1), a1 + hstep, voffA);
            PG8_WAIT_V(8); PG8_WAIT_L(0); PG8_BAR; PG8_MMA(0, 0, At, B0); PG8_MMA(0, 1, At, B1); PG8_BAR; PG8_SCHED;
            PG8_LDA(At, 0, 1); PG8_STAGE(PG8_SB(0, 0), b2, voffB); PG8_STAGE(PG8_SB(0, 1), b2 + hstep, voffB); PG8_STAGE(PG8_SA(0, 0), a2, voffA);
            PG8_WAIT_V(8); PG8_WAIT_L(0); PG8_BAR; PG8_MMA(1, 0, At, B0); PG8_MMA(1, 1, At, B1); PG8_BAR; PG8_SCHED;
            PG8_LDB(B0, 1, 0); PG8_LDB(B1, 1, 1); PG8_SCHED; PG8_LDA(At, 1, 0); PG8_STAGE(PG8_SA(0, 1), a2 + hstep, voffA);
            PG8_WAIT_V(8); PG8_WAIT_L(0); PG8_BAR; PG8_MMA(0, 0, At, B0); PG8_MMA(0, 1, At, B1); PG8_BAR; PG8_SCHED;
            PG8_LDA(At, 1, 1); PG8_STAGE(PG8_SB(1, 0), b3, voffB); PG8_STAGE(PG8_SB(1, 1), b3 + hstep, voffB); PG8_STAGE(PG8_SA(1, 0), a3, voffA);
            PG8_WAIT_V(8); PG8_WAIT_L(0); PG8_BAR; PG8_MMA(1, 0, At, B0); PG8_MMA(1, 1, At, B1); PG8_BAR; PG8_SCHED;
            } else {
            PG8_LDB(B0, 0, 0); PG8_SCHED; PG8_LDA(At, 0, 0); PG8_STAGE(PG8_SA(1, 1), a1 + hstep, voffA);
            PG8_WAIT_L(8); PG8_BAR; PG8_WAIT_L(0); PG8_MMA(0, 0, At, B0); PG8_BAR; PG8_SCHED;
            PG8_LDB(B1, 0, 1); PG8_STAGE(PG8_SB(0, 0), b2, voffB);
            PG8_BAR; PG8_WAIT_L(0); PG8_MMA(0, 1, At, B1); PG8_BAR;
            PG8_LDA(At, 0, 1); PG8_STAGE(PG8_SA(0, 0), a2, voffA);
            PG8_BAR; PG8_WAIT_L(0); PG8_MMA(1, 0, At, B0); PG8_BAR; PG8_SCHED;
            PG8_STAGE(PG8_SB(0, 1), b2 + hstep, voffB);
            PG8_WAIT_V(6); PG8_BAR; PG8_MMA(1, 1, At, B1); PG8_BAR;
            PG8_LDB(B0, 1, 0); PG8_SCHED; PG8_LDA(At, 1, 0); PG8_STAGE(PG8_SA(0, 1), a2 + hstep, voffA);
            PG8_WAIT_L(8); PG8_BAR; PG8_WAIT_L(0); PG8_MMA(0, 0, At, B0); PG8_BAR; PG8_SCHED;
            PG8_LDB(B1, 1, 1); PG8_STAGE(PG8_SB(1, 0), b3, voffB);
            PG8_BAR; PG8_WAIT_L(0); PG8_MMA(0, 1, At, B1); PG8_BAR;
            PG8_LDA(At, 1, 1); PG8_STAGE(PG8_SA(1, 0), a3, voffA);
            PG8_BAR; PG8_WAIT_L(0); PG8_MMA(1, 0, At, B0); PG8_BAR; PG8_SCHED;
            PG8_STAGE(PG8_SB(1, 1), b3 + hstep, voffB);
            PG8_WAIT_V(6); PG8_BAR; PG8_MMA(1, 1, At, B1); PG8_BAR;
            }
        }
        if constexpr (ALIGN_EPI) { if (wr == 0) PG8_BAR; }
        if constexpr (!Epi::AFTER_DRAIN) { E(acc, cur, wr, wc, fr, fq); S.done(cur); }
        if (!has_next) break;
#pragma unroll
        for (int a = 0; a < 2; ++a)
#pragma unroll
            for (int b = 0; b < 2; ++b)
#pragma unroll
                for (int m = 0; m < 4; ++m)
#pragma unroll
                    for (int n = 0; n < 2; ++n) acc[a][b][m][n] = (f32x4){0.f, 0.f, 0.f, 0.f};
        cur = nxt; cA = nA; cB = nB; nt = cur.nt; ++ui; S.prefetch(cur, wr, fr);
        if constexpr (ALIGN_EPI) { if (wr == 1) PG8_BAR; }
    }
    PG8_WAIT_V(0);
    if constexpr (!ALIGN_EPI) { if (wr == 0) PG8_BAR; }
    PG8_BAR;
    if constexpr (Epi::AFTER_DRAIN) { E.fused(acc, cur, wr, wc, fr, fq, lds, wid, lane); S.done(cur); }
#undef PG8_SA
#undef PG8_SB
#undef PG8_STAGE
#undef PG8_LDA
#undef PG8_LDB
#undef PG8_MMA
#undef PG8_WAIT_V
#undef PG8_WAIT_L
#undef PG8_BAR
#undef PG8_SCHED
}
}

#ifndef MK_N_LAUNCHES
#define MK_N_LAUNCHES 1
#endif
#ifndef DUP_MASK
#define DUP_MASK 0
#endif
using pg8::bf16_t; using pg8::bf16x8; using pg8::f32x4; using pg8::u32x4; using pg8::cvt_pk_bf16;
#define LAS __attribute__((address_space(3)))
typedef float f32x16 __attribute__((ext_vector_type(16)));
typedef float f32x2v __attribute__((ext_vector_type(2)));
typedef unsigned u32x2 __attribute__((ext_vector_type(2)));
typedef short s16x4 __attribute__((ext_vector_type(4)));

constexpr int DM = 1024, NP = 16384  , NS = 2048  , MT = NP + NS  ;
constexpr int TP = 2048, TS = 64, BP = 8, BS = 32;
constexpr int LW = 768, AW = 768, MW = 256, DFF = 2816;
constexpr int NINA = 2 * LW + MW;
constexpr int NKVQ = 2 * AW + AW + MW;
constexpr int NMEMR = BP * 256;
constexpr float RMS_EPS = 1e-6f;
constexpr float LOG2E = 1.4426950408889634f;

constexpr size_t O_Y = 0;
constexpr size_t O_CONVP = (size_t)MT * DM;
constexpr size_t O_LRUP = O_CONVP + (size_t)BP * 3 * LW;
constexpr size_t O_CKP = O_LRUP + (size_t)BP * LW;
constexpr size_t O_CVP = O_CKP + (size_t)BP * 512 * AW;
constexpr size_t O_MKP = O_CVP + (size_t)BP * 512 * AW;
constexpr size_t O_MVP = O_MKP + (size_t)2 * BP * 256 * MW;
constexpr size_t O_CONVS = O_MVP + (size_t)2 * BP * 256 * MW;
constexpr size_t O_LRUS = O_CONVS + (size_t)BS * 3 * LW;
constexpr size_t O_KS = O_LRUS + (size_t)BS * LW;
constexpr size_t O_VS = O_KS + (size_t)BS * TS * AW;
constexpr size_t O_END = O_VS + (size_t)BS * TS * AW;

constexpr size_t MiB = 1u << 20;
constexpr size_t WS_WINA = 0, WS_WKVB = 4 * MiB, WS_WMEM = 9 * MiB, WS_WOUT = 11 * MiB, WS_WGU = 15 * MiB, WS_WDN = 37 * MiB;
constexpr size_t WS_WG = 48 * MiB, WS_CAR = 49 * MiB, WS_MN = 51 * MiB, WS_MKV = 55 * MiB, WS_XN = 59 * MiB, WS_KV = 95 * MiB;
constexpr size_t WS_H = 149 * MiB, WS_PROJ = WS_H, WS_MIX = 212 * MiB, WS_PART = 248 * MiB, WS_END = 280 * MiB;
constexpr size_t WS_SS = WS_CAR + 3 * MiB / 2;
constexpr size_t WS_BAR = 51 * MiB - 128 * 1024;
constexpr int NSPLIT = 8;
static_assert(WS_PROJ + (size_t)MT * NINA * 2 <= WS_MIX && WS_MIX + (size_t)MT * DM * 2 <= WS_END && WS_H + (size_t)MT * DFF * 2 <= WS_END, "ws map");

constexpr int LDS_BYTES = 131072 + 1024;

__device__ __forceinline__ unsigned f2bf(float f) { unsigned u = __builtin_bit_cast(unsigned, f); return (u + 0x7fffu + ((u >> 16) & 1u)) >> 16; }
__device__ __forceinline__ float bf2f(bf16_t b) { return __builtin_bit_cast(float, (unsigned)b << 16); }
__device__ __forceinline__ float wave_sum(float v) {
#pragma unroll
    for (int o = 1; o < 64; o <<= 1) v += __shfl_xor(v, o);
    return v;
}
#define LDS_WAIT() asm volatile("s_waitcnt lgkmcnt(0)" ::: "memory")

typedef const f32x4 (&AccRef)[2][2][4][2];
__device__ __forceinline__ u32x4 pack8(f32x4 v0, f32x4 v1) { u32x4 w; w.x = cvt_pk_bf16(v0[0], v0[1]); w.y = cvt_pk_bf16(v0[2], v0[3]); w.z = cvt_pk_bf16(v1[0], v1[1]); w.w = cvt_pk_bf16(v1[2], v1[3]); return w; }

__device__ __forceinline__ float rstd_of(float ss) { return 1.0f / sqrtf(ss * (1.0f / DM) + RMS_EPS); }
struct EpiBf16Plain {
    static constexpr bool PERM = true, AFTER_DRAIN = false;
    bf16_t* O; int ldc; const float* pre;
    __device__ __forceinline__ void operator()(AccRef acc, const pg8::Unit& u, int wr, int wc, int fr, int fq) const {
        const int row0 = u.pm * 256 + wr * 64 + fr, col0 = u.pn * 256 + wc * 32 + 8 * fq;
#pragma unroll
        for (int ai = 0; ai < 2; ++ai)
#pragma unroll
            for (int m = 0; m < 4; ++m) { const int r = row0 + ai * 128 + m * 16; bf16_t* rowp = O + (size_t)r * ldc + col0; const float rs = rstd_of(pre[ai * 4 + m]);
#pragma unroll
                for (int bj = 0; bj < 2; ++bj) *(u32x4*)(rowp + bj * 128) = pack8(acc[ai][bj][m][0] * rs, acc[ai][bj][m][1] * rs); }
    }
};
struct EpiMemKV {
    static constexpr bool PERM = true, AFTER_DRAIN = false;
    bf16_t* O; float* out;
    __device__ __forceinline__ void operator()(AccRef acc, const pg8::Unit& u, int wr, int wc, int fr, int fq) const {
        const int row0 = u.pm * 256 + wr * 64 + fr, col0 = u.pn * 256 + wc * 32 + 8 * fq;
        const int l = u.pn >> 1, isv = u.pn & 1;
        float* fo = out + (isv ? O_MVP : O_MKP) + (size_t)l * (BP * 256 * MW) + wc * 32 + 8 * fq;
#pragma unroll
        for (int ai = 0; ai < 2; ++ai)
#pragma unroll
            for (int m = 0; m < 4; ++m) { const int r = row0 + ai * 128 + m * 16; bf16_t* rowp = O + (size_t)r * 1024 + col0; float* fr_ = fo + (size_t)r * MW;
#pragma unroll
                for (int bj = 0; bj < 2; ++bj) { *(u32x4*)(rowp + bj * 128) = pack8(acc[ai][bj][m][0], acc[ai][bj][m][1]);
                    *(f32x4*)(fr_ + bj * 128) = acc[ai][bj][m][0]; *(f32x4*)(fr_ + bj * 128 + 4) = acc[ai][bj][m][1]; } }
    }
};
struct EpiKVQ {
    static constexpr bool PERM = true, AFTER_DRAIN = false;
    bf16_t* KV; bf16_t* QB; float* out; const float* pre;
    __device__ __forceinline__ void operator()(AccRef acc, const pg8::Unit& u, int wr, int wc, int fr, int fq) const {
        const int rl0 = wr * 64 + fr, cl0 = wc * 32 + 8 * fq;
        if (u.pn >= 6) {
            bf16_t* base = QB + (size_t)(u.pm * 256 + rl0) * 1024 + (u.pn - 6) * 256 + cl0;
#pragma unroll
            for (int ai = 0; ai < 2; ++ai)
#pragma unroll
                for (int m = 0; m < 4; ++m) { const float rs = rstd_of(pre[ai * 4 + m]);
#pragma unroll
                    for (int bj = 0; bj < 2; ++bj) *(u32x4*)(base + (size_t)(ai * 128 + m * 16) * 1024 + bj * 128) = pack8(acc[ai][bj][m][0] * rs, acc[ai][bj][m][1] * rs); }
            return;
        }
        bf16_t* base = KV + (size_t)(u.pm * 256 + rl0) * 1536 + u.pn * 256 + cl0;
        const int isv = u.pn >= 3, ckv = (u.pn % 3) * 256 + cl0;
        float* fo = nullptr;
        if (u.pm >= 64) fo = out + (isv ? O_VS : O_KS) + (size_t)((u.pm - 64) * 256 + rl0) * AW + ckv;
        else if ((u.pm & 7) >= 6) fo = out + (isv ? O_CVP : O_CKP) + (size_t)((u.pm >> 3) * 512 + ((u.pm & 7) - 6) * 256 + rl0) * AW + ckv;
#pragma unroll
        for (int ai = 0; ai < 2; ++ai)
#pragma unroll
            for (int m = 0; m < 4; ++m) { const float rs = rstd_of(pre[ai * 4 + m]);
#pragma unroll
                for (int bj = 0; bj < 2; ++bj) { const f32x4 v0 = acc[ai][bj][m][0] * rs, v1 = acc[ai][bj][m][1] * rs;
                    *(u32x4*)(base + (size_t)(ai * 128 + m * 16) * 1536 + bj * 128) = pack8(v0, v1);
                    if (fo) { float* f = fo + (size_t)(ai * 128 + m * 16) * AW + bj * 128; *(f32x4*)f = v0; *(f32x4*)(f + 4) = v1; } } }
    }
};
__device__ __forceinline__ float silu_f(float x) { return x * __builtin_amdgcn_rcpf(1.0f + __expf(-x)); }
struct EpiSwiGLU {
    static constexpr bool PERM = true, AFTER_DRAIN = false;
    bf16_t* H; const float* pre;
    __device__ __forceinline__ void operator()(AccRef acc, const pg8::Unit& u, int wr, int wc, int fr, int fq) const {
        const int r0 = u.pm * 256 + wr * 64 + fr;
        bf16_t* base = H + (size_t)r0 * DFF + u.pn * 128 + wc * 32 + 8 * fq;
#pragma unroll
        for (int ai = 0; ai < 2; ++ai)
#pragma unroll
            for (int m = 0; m < 4; ++m) { f32x4 v0, v1; const float rs = rstd_of(pre[ai * 4 + m]);
#pragma unroll
                for (int j = 0; j < 4; ++j) { v0[j] = silu_f(acc[ai][0][m][0][j] * rs) * (acc[ai][1][m][0][j] * rs); v1[j] = silu_f(acc[ai][0][m][1][j] * rs) * (acc[ai][1][m][1][j] * rs); }
                *(u32x4*)(base + (size_t)(ai * 128 + m * 16) * DFF) = pack8(v0, v1); }
    }
};
__device__ __forceinline__ f32x4 unpack4(u32x2 w) { f32x4 v; v[0] = __builtin_bit_cast(float, w.x << 16); v[1] = __builtin_bit_cast(float, w.x & 0xffff0000u); v[2] = __builtin_bit_cast(float, w.y << 16); v[3] = __builtin_bit_cast(float, w.y & 0xffff0000u); return v; }
struct EpiResid {
    static constexpr bool PERM = false, AFTER_DRAIN = false;
    const float* basef; const bf16_t* baseh; float* Xf; bf16_t* XN; float* ss; bf16_t* PART; float sc;
    __device__ __forceinline__ void operator()(AccRef acc, const pg8::Unit& u, int wr, int wc, int fr, int fq) const {
        const int col0 = u.pn * 256 + wc * 32 + 4 * fq;
        if (u.pm >= 64) {
            bf16_t* pb = PART + ((size_t)u.sp * NS + (u.pm - 64) * 256 + wr * 64 + fr) * DM + col0;
#pragma unroll
            for (int ai = 0; ai < 2; ++ai)
#pragma unroll
                for (int m = 0; m < 4; ++m)
#pragma unroll
                    for (int bj = 0; bj < 2; ++bj)
#pragma unroll
                        for (int n = 0; n < 2; ++n) { const f32x4 v = acc[ai][bj][m][n] * sc; u32x2 w; w.x = cvt_pk_bf16(v[0], v[1]); w.y = cvt_pk_bf16(v[2], v[3]);
                            *(u32x2*)(pb + (size_t)(ai * 128 + m * 16) * DM + bj * 128 + n * 16) = w; }
            return;
        }
#pragma unroll
        for (int ai = 0; ai < 2; ++ai)
#pragma unroll
            for (int m = 0; m < 4; ++m) { const int r = u.pm * 256 + ai * 128 + wr * 64 + m * 16 + fr; const size_t off = (size_t)r * DM + col0; float sq = 0.f;
                f32x4 bv[2][2];
#pragma unroll
                for (int bj = 0; bj < 2; ++bj)
#pragma unroll
                    for (int n = 0; n < 2; ++n) bv[bj][n] = basef ? *(const f32x4*)(basef + off + bj * 128 + n * 16) : unpack4(*(const u32x2*)(baseh + off + bj * 128 + n * 16));
#pragma unroll
                for (int bj = 0; bj < 2; ++bj)
#pragma unroll
                    for (int n = 0; n < 2; ++n) { const f32x4 v = bv[bj][n] + acc[ai][bj][m][n] * sc;
                        if (Xf) *(f32x4*)(Xf + off + bj * 128 + n * 16) = v;
                        sq += (v[0] * v[0] + v[1] * v[1]) + (v[2] * v[2] + v[3] * v[3]);
                        if (XN) { u32x2 w; w.x = cvt_pk_bf16(v[0], v[1]); w.y = cvt_pk_bf16(v[2], v[3]); *(u32x2*)(XN + off + bj * 128 + n * 16) = w; } }
                if (ss) { sq += __shfl_xor(sq, 16); sq += __shfl_xor(sq, 32); if (fq == 0) __hip_atomic_fetch_add(ss + r, sq * sc, __ATOMIC_RELAXED, __HIP_MEMORY_SCOPE_AGENT); }
                if (m & 1) asm volatile("" ::: "memory"); }
    }
};
template <class Epi> __device__ __forceinline__ void run_gemm(LAS unsigned char* lds, const bf16_t* A, const bf16_t* Bt, int M, int N, int K, const Epi& E) {
    pg8::Gemm g{A, Bt, M, N, K}; pg8::StaticOrder S; S.init(M, N, K, (int)gridDim.x, (int)blockIdx.x);
    pg8::gemm_phase<Epi, pg8::StaticOrder, true, true>(lds, g, S, E);
}
template <class Epi> __device__ __forceinline__ void run_gemm_ss(LAS unsigned char* lds, const bf16_t* A, const bf16_t* Bt, int M, int N, int K, Epi E, const float* ss) {
    pg8::Gemm g{A, Bt, M, N, K}; pg8::StaticOrder S; S.init(M, N, K, (int)gridDim.x, (int)blockIdx.x); S.ssrc = ss; E.pre = S.pre;
    pg8::gemm_phase<Epi, pg8::StaticOrder, true, true>(lds, g, S, E);
}
__device__ __forceinline__ void run_gemm_resid(LAS unsigned char* lds, const bf16_t* A, const bf16_t* Bt, int K, const EpiResid& E) {
    pg8::Gemm g{A, Bt, MT, 1024, K}; pg8::ResidOrder S; S.init(K, (int)gridDim.x, (int)blockIdx.x);
    pg8::gemm_phase<EpiResid, pg8::ResidOrder, true, true>(lds, g, S, E);
}
__device__ __forceinline__ float reduce_row_regs(const float* browf, const bf16_t* browh, const bf16_t* PART, int srow, int lane, f32x4 (&v)[4]) {
    float s = 0.f;
#pragma unroll
    for (int j = 0; j < 4; ++j) v[j] = browf ? ((const f32x4*)browf)[lane + 64 * j] : unpack4(((const u32x2*)browh)[lane + 64 * j]);
#pragma unroll
    for (int sp = 0; sp < NSPLIT; ++sp) { const u32x2* p = (const u32x2*)(PART + ((size_t)sp * NS + srow) * DM) + lane;
#pragma unroll
        for (int j = 0; j < 4; ++j) v[j] += unpack4(p[64 * j]); }
#pragma unroll
    for (int j = 0; j < 4; ++j) s += (v[j][0] * v[j][0] + v[j][1] * v[j][1]) + (v[j][2] * v[j][2] + v[j][3] * v[j][3]);
    return wave_sum(s);
}
__device__ __forceinline__ void reduce_row(const float* browf, const bf16_t* browh, const bf16_t* PART, int srow, bf16_t* xnrow, float* ssp, int lane) {
    f32x4 v[4]; const float s = reduce_row_regs(browf, browh, PART, srow, lane, v);
#pragma unroll
    for (int j = 0; j < 4; ++j) { u32x2 w; w.x = cvt_pk_bf16(v[j][0], v[j][1]); w.y = cvt_pk_bf16(v[j][2], v[j][3]); ((u32x2*)xnrow)[lane + 64 * j] = w; }
    if (lane == 0) *ssp = s;
}

__device__ __forceinline__ void transpose_item(const float* W, int N, const float* g, bf16_t* WT, int K, int k0, int n0, int drow0, LAS float* scr, int lane) {
#pragma unroll 8
    for (int i = 0; i < 32; ++i) { const int kk = 2 * i + (lane >> 5); float v = W[(size_t)(k0 + kk) * N + n0 + (lane & 31)]; if (g) v *= g[k0 + kk]; scr[kk * 33 + (lane & 31)] = v; }
    LDS_WAIT();
    const int c = lane & 7;
#pragma unroll
    for (int j = 0; j < 4; ++j) { const int n = (lane >> 3) + 8 * j; const LAS float* s = scr + (8 * c) * 33 + n;
        u32x4 o; o.x = cvt_pk_bf16(s[0 * 33], s[1 * 33]); o.y = cvt_pk_bf16(s[2 * 33], s[3 * 33]); o.z = cvt_pk_bf16(s[4 * 33], s[5 * 33]); o.w = cvt_pk_bf16(s[6 * 33], s[7 * 33]);
        *(u32x4*)(WT + (size_t)(drow0 + n) * K + k0 + 8 * c) = o; }
    LDS_WAIT();
}
__device__ __forceinline__ void norm_row_bf16(const float* xrow, bf16_t* orow, int lane) {
    const f32x4* xr = (const f32x4*)xrow + lane; f32x4 v[4]; float s = 0.f;
#pragma unroll
    for (int j = 0; j < 4; ++j) { v[j] = xr[64 * j]; s += (v[j][0] * v[j][0] + v[j][1] * v[j][1]) + (v[j][2] * v[j][2] + v[j][3] * v[j][3]); }
    const float rstd = 1.0f / sqrtf(wave_sum(s) * (1.0f / DM) + RMS_EPS);
    u32x2* o8 = (u32x2*)orow + lane;
#pragma unroll
    for (int j = 0; j < 4; ++j) { u32x2 w; w.x = cvt_pk_bf16(v[j][0] * rstd, v[j][1] * rstd); w.y = cvt_pk_bf16(v[j][2] * rstd, v[j][3] * rstd); o8[64 * j] = w; }
}
__device__ __forceinline__ void norm_row2_bf16(const float* xrow, bf16_t* orow, float* ssp, int lane) {
    const f32x4* xr = (const f32x4*)xrow + lane; f32x4 v[8]; float s0 = 0.f, s1 = 0.f;
#pragma unroll
    for (int j = 0; j < 8; ++j) v[j] = xr[64 * j];
#pragma unroll
    for (int j = 0; j < 4; ++j) { s0 += (v[j][0] * v[j][0] + v[j][1] * v[j][1]) + (v[j][2] * v[j][2] + v[j][3] * v[j][3]); s1 += (v[4 + j][0] * v[4 + j][0] + v[4 + j][1] * v[4 + j][1]) + (v[4 + j][2] * v[4 + j][2] + v[4 + j][3] * v[4 + j][3]); }
    s0 = wave_sum(s0); s1 = wave_sum(s1);
    float r0 = 1.0f, r1 = 1.0f;
    if (ssp) { if (lane == 0) { ssp[0] = s0; ssp[1] = s1; } } else { r0 = 1.0f / sqrtf(s0 * (1.0f / DM) + RMS_EPS); r1 = 1.0f / sqrtf(s1 * (1.0f / DM) + RMS_EPS); }
    u32x2* o8 = (u32x2*)orow + lane;
#pragma unroll
    for (int j = 0; j < 8; ++j) { const float rs = j < 4 ? r0 : r1; u32x2 w; w.x = cvt_pk_bf16(v[j][0] * rs, v[j][1] * rs); w.y = cvt_pk_bf16(v[j][2] * rs, v[j][3] * rs); o8[64 * j] = w; }
}
__device__ __forceinline__ void norm_row2_final_h(const bf16_t* xrow, float* yrow, const float* g, int lane) {
    const u32x2* xr = (const u32x2*)xrow + lane; const f32x4* gr = (const f32x4*)g + lane; u32x2 w[8]; f32x4 v[8]; float s0 = 0.f, s1 = 0.f;
#pragma unroll
    for (int j = 0; j < 8; ++j) w[j] = xr[64 * j];
#pragma unroll
    for (int j = 0; j < 8; ++j) { v[j][0] = __builtin_bit_cast(float, w[j].x << 16); v[j][1] = __builtin_bit_cast(float, w[j].x & 0xffff0000u); v[j][2] = __builtin_bit_cast(float, w[j].y << 16); v[j][3] = __builtin_bit_cast(float, w[j].y & 0xffff0000u);
        const float q = (v[j][0] * v[j][0] + v[j][1] * v[j][1]) + (v[j][2] * v[j][2] + v[j][3] * v[j][3]); if (j < 4) s0 += q; else s1 += q; }
    const float r0 = 1.0f / sqrtf(wave_sum(s0) * (1.0f / DM) + RMS_EPS), r1 = 1.0f / sqrtf(wave_sum(s1) * (1.0f / DM) + RMS_EPS);
#pragma unroll
    for (int j = 0; j < 8; ++j) ((f32x4*)yrow)[lane + 64 * j] = v[j] * (j < 4 ? r0 : r1) * gr[64 * (j & 3)];
}
__device__ __forceinline__ void norm_row_final_h(const bf16_t* xrow, float* yrow, const float* g, int lane) {
    const u32x2* xr = (const u32x2*)xrow + lane; const f32x4* gr = (const f32x4*)g + lane; f32x4 v[4]; float s = 0.f;
#pragma unroll
    for (int j = 0; j < 4; ++j) { const u32x2 w = xr[64 * j]; v[j][0] = __builtin_bit_cast(float, w.x << 16); v[j][1] = __builtin_bit_cast(float, w.x & 0xffff0000u); v[j][2] = __builtin_bit_cast(float, w.y << 16); v[j][3] = __builtin_bit_cast(float, w.y & 0xffff0000u);
        s += (v[j][0] * v[j][0] + v[j][1] * v[j][1]) + (v[j][2] * v[j][2] + v[j][3] * v[j][3]); }
    const float rstd = 1.0f / sqrtf(wave_sum(s) * (1.0f / DM) + RMS_EPS);
#pragma unroll
    for (int j = 0; j < 4; ++j) ((f32x4*)yrow)[lane + 64 * j] = v[j] * rstd * gr[64 * j];
}
__device__ __forceinline__ void norm_row_final(float* xrow, const float* g, int lane) {
    f32x4* xr = (f32x4*)xrow + lane; const f32x4* gr = (const f32x4*)g + lane; f32x4 v[4]; float s = 0.f;
#pragma unroll
    for (int j = 0; j < 4; ++j) { v[j] = xr[64 * j]; s += (v[j][0] * v[j][0] + v[j][1] * v[j][1]) + (v[j][2] * v[j][2] + v[j][3] * v[j][3]); }
    const float rstd = 1.0f / sqrtf(wave_sum(s) * (1.0f / DM) + RMS_EPS);
#pragma unroll
    for (int j = 0; j < 4; ++j) xr[64 * j] = v[j] * rstd * gr[64 * j];
}

struct Args { const float* in[29]; float* out; unsigned char* ws; int ph_lo, ph_hi; int flags, pad; };


constexpr int I_INA = 16 * 56, I_KV = 16 * 48, I_INB = 16 * 32, I_MEM = 16 * 16, I_OUT = 16 * 32, I_GU = 16 * 176, I_DN = 44 * 32;
constexpr int W_EARLY = I_INA + 2 * I_MEM;
constexpr int W_ALL = W_EARLY + I_KV + I_INB + 2 * I_OUT + 2 * I_GU + 2 * I_DN;
constexpr int WB_KV = W_EARLY, WB_OUT = WB_KV + I_KV + I_INB, WB_GU = WB_OUT + 2 * I_OUT, WB_DN = WB_GU + 2 * I_GU;
constexpr int W_P1 = I_OUT + I_GU + I_DN;
constexpr int W_P6 = I_KV + I_INB + I_OUT + I_GU + I_DN;
__device__ __forceinline__ int witem_p1(int q) { if (q < I_OUT) return WB_OUT + q; q -= I_OUT; if (q < I_GU) return WB_GU + q; return WB_DN + (q - I_GU); }
__device__ __forceinline__ int witem_p6(int q) { if (q < I_KV + I_INB) return WB_KV + q; q -= I_KV + I_INB; if (q < I_OUT) return WB_OUT + I_OUT + q; q -= I_OUT; if (q < I_GU) return WB_GU + I_GU + q; return WB_DN + I_DN + (q - I_GU); }
__device__ __forceinline__ void weight_item(const Args& a, int r, LAS float* scr, int lane) {
    unsigned char* ws = a.ws;
    bf16_t* WINA = (bf16_t*)(ws + WS_WINA); bf16_t* WKVB = (bf16_t*)(ws + WS_WKVB); bf16_t* WMEM = (bf16_t*)(ws + WS_WMEM); bf16_t* WOUT = (bf16_t*)(ws + WS_WOUT);
    bf16_t* WGU = (bf16_t*)(ws + WS_WGU); bf16_t* WDN = (bf16_t*)(ws + WS_WDN);
    if (r < I_INA) { const int kb = r / 56, nb = r % 56; transpose_item(a.in[12], NINA, a.in[9], WINA, 1024, kb * 64, nb * 32, nb * 32, scr, lane); return; } r -= I_INA;
    if (r < 2 * I_MEM) { const int l = r / I_MEM; r %= I_MEM; const int kb = r / 16, nb = r % 16; transpose_item(a.in[25] + (size_t)l * 1024 * 512, 512, a.in[24] + l * 1024, WMEM, 1024, kb * 64, nb * 32, l * 512 + nb * 32, scr, lane); return; } r -= 2 * I_MEM;
    if (r < I_KV) { const int kb = r / 48, nb = r % 48; transpose_item(a.in[21], 1536, a.in[20], WKVB, 1024, kb * 64, nb * 32, nb * 32, scr, lane); return; } r -= I_KV;
    if (r < I_INB) { const int kb = r / 32, nb = r % 32; transpose_item(a.in[22], 1024, a.in[9] + 1024, WKVB, 1024, kb * 64, nb * 32, 1536 + nb * 32, scr, lane); return; } r -= I_INB;
    if (r < 2 * I_OUT) { const int l = r / I_OUT; r %= I_OUT; const int kb = r / 32, nb = r % 32; transpose_item(a.in[26] + (size_t)l * 1024 * 1024, 1024, nullptr, WOUT + (size_t)l * 1024 * 1024, 1024, kb * 64, nb * 32, nb * 32, scr, lane); return; } r -= 2 * I_OUT;
    if (r < 2 * I_GU) { const int l = r / I_GU; r %= I_GU; const int kb = r / 176, nb = r % 176; const int c = nb * 32, bj = c / DFF, cp = c % DFF;
        transpose_item(a.in[27] + (size_t)l * 1024 * 2 * DFF, 2 * DFF, a.in[10] + l * 1024, WGU + (size_t)l * 2 * DFF * 1024, 1024, kb * 64, c, 256 * (cp / 128) + 128 * bj + (cp % 128), scr, lane); return; } r -= 2 * I_GU;
    { const int l = r / I_DN; r %= I_DN; const int kb = r / 32, nb = r % 32; transpose_item(a.in[28] + (size_t)l * DFF * 1024, 1024, nullptr, WDN + (size_t)l * 1024 * DFF, DFF, kb * 64, nb * 32, nb * 32, scr, lane); }
}

__device__ __forceinline__ float sigmoid_f(float x) { return __builtin_amdgcn_rcpf(1.0f + __builtin_amdgcn_exp2f(-1.4426950408889634f * x)); }
__device__ __forceinline__ float gelu_tanh(float x) { const float t = (-1.5957691216057308f * 1.4426950408889634f) * (x + 0.044715f * x * x * x); return x * __builtin_amdgcn_rcpf(1.0f + __builtin_amdgcn_exp2f(t)); }
__device__ __forceinline__ float neg_expm1(float t, float av) {
    const float p = -t * (1.0f + t * (0.5f + t * (0.16666667f + t * (0.041666668f + t * (0.0083333338f + t * 0.0013888889f)))));
    return t > -0.25f ? p : 1.0f - av * av;
}
template <int PASS> __device__ __forceinline__ void scan_item(const Args& a, int chunk, int nb, LAS unsigned char* wl, int lane) {
    unsigned char* ws = a.ws;
    const bf16_t* PROJ = (const bf16_t*)(ws + WS_PROJ); bf16_t* MIX = (bf16_t*)(ws + WS_MIX);
    float* CA = (float*)(ws + WS_CAR); float* CH = CA + 256 * LW;
    const bf16_t* WGT = (const bf16_t*)(ws + WS_WG);
    const int cgi = nb * 64 + lane;
    const bool isp = chunk < 256; const int b = isp ? (chunk >> 5) : (chunk - 256), c = isp ? (chunk & 31) : 0;
    const int row0 = isp ? b * TP + c * 64 : NP + b * TS;
    const bf16_t* xp = PROJ + (size_t)row0 * NINA + cgi;
    const float w0 = a.in[13][0 * LW + cgi], w1 = a.in[13][1 * LW + cgi], w2 = a.in[13][2 * LW + cgi], w3 = a.in[13][3 * LW + cgi], cb = a.in[14][cgi];
    float xm1, xm2, xm3;
    if (isp) { if (c == 0) { xm1 = xm2 = xm3 = 0.f; } else { xm3 = bf2f(*(xp - 3 * NINA)); xm2 = bf2f(*(xp - 2 * NINA)); xm1 = bf2f(*(xp - NINA)); } }
    else { const float* sc = a.in[2] + (size_t)b * 3 * LW + cgi; xm3 = sc[0]; xm2 = sc[LW]; xm1 = sc[2 * LW]; }
    const float lam = a.in[19][cgi]; const float c8 = -8.0f * log1pf(__expf(-lam));
    const float ba = a.in[16][cgi], bi = a.in[18][cgi];
    const int fr = lane & 15, fq = lane >> 4;
    bf16x8 wa[4][2], wi[4][2];
#pragma unroll
    for (int jb = 0; jb < 4; ++jb)
#pragma unroll
        for (int kb = 0; kb < 2; ++kb) {
            wa[jb][kb] = *(const bf16x8*)(WGT + (size_t)((0 * 12 + nb) * 64 + jb * 16 + fr) * 64 + kb * 32 + fq * 8);
            wi[jb][kb] = *(const bf16x8*)(WGT + (size_t)((1 * 12 + nb) * 64 + jb * 16 + fr) * 64 + kb * 32 + fq * 8); }
    LAS bf16_t* xcT = (LAS bf16_t*)wl;
    LAS float* Ab = (LAS float*)(wl + 2304);
    LAS float* Gb = (LAS float*)(wl + 6656);
    float h = 0.f, ap = 1.f;
    if (PASS == 2) {
        if (isp) { const float* pa = CA + (size_t)(b * 32) * LW + cgi; const float* ph = CH + (size_t)(b * 32) * LW + cgi;
            for (int cq = 0; cq < c; cq += 8) { float av[8], hv[8];
#pragma unroll
                for (int k = 0; k < 8; ++k) { const int cc = (cq + k < c) ? cq + k : c - 1; av[k] = pa[(size_t)cc * LW]; hv[k] = ph[(size_t)cc * LW]; }
#pragma unroll
                for (int k = 0; k < 8; ++k) if (cq + k < c) h = av[k] * h + hv[k]; } }
        else h = a.in[3][(size_t)b * LW + cgi];
    }
    const bool reset = isp && c == 0;
    LAS bf16_t* xs = (LAS bf16_t*)(wl + 11264); LAS bf16_t* gs = (LAS bf16_t*)(wl + 13312);
    const int lr = lane >> 3, lp = lane & 7;
    const bf16_t* tp0 = PROJ + (size_t)(row0 + lr) * NINA + nb * 64 + lp * 8;
    u32x4 px0 = *(const u32x4*)tp0, px1 = *(const u32x4*)(tp0 + (size_t)8 * NINA), pg0, pg1;
    if (PASS == 2) { pg0 = *(const u32x4*)(tp0 + LW); pg1 = *(const u32x4*)(tp0 + (size_t)8 * NINA + LW); }
    *(LAS u32x4*)(xs + lr * 64 + lp * 8) = px0; *(LAS u32x4*)(xs + (lr + 8) * 64 + lp * 8) = px1;
    if (PASS == 2) { *(LAS u32x4*)(gs + lr * 64 + lp * 8) = pg0; *(LAS u32x4*)(gs + (lr + 8) * 64 + lp * 8) = pg1; }
    LDS_WAIT();
    const float ban = -LOG2E * ba, bin = -LOG2E * bi, c8l = c8 * LOG2E, c8x2 = 2.0f * c8;
    constexpr float GK1 = -1.5957691216057308f * LOG2E, GK3 = GK1 * 0.044715f;
#pragma unroll 1
    for (int tb = 0; tb < 4; ++tb) {
        f32x2v xc2[8];
        if (tb < 3) { const bf16_t* tpn = tp0 + (size_t)((tb + 1) * 16) * NINA;
            px0 = *(const u32x4*)tpn; px1 = *(const u32x4*)(tpn + (size_t)8 * NINA);
            if (PASS == 2) { pg0 = *(const u32x4*)(tpn + LW); pg1 = *(const u32x4*)(tpn + (size_t)8 * NINA + LW); } }
        asm volatile("" ::: "memory");
#pragma unroll
        for (int tp = 0; tp < 8; ++tp) {
            const float x0 = bf2f(xs[(2 * tp) * 64 + lane]), x1 = bf2f(xs[(2 * tp + 1) * 64 + lane]);
            const f32x2v xa = {x0, x1}, xb = {xm1, x0}, xcv = {xm2, xm1}, xd = {xm3, xm2};
            const f32x2v v = cb + w3 * xa + w2 * xb + w1 * xcv + w0 * xd;
            xc2[tp] = v; xm3 = xm1; xm2 = x0; xm1 = x1;
            const unsigned pk = cvt_pk_bf16(v.x, v.y);
            xcT[(2 * tp) * 72 + lane] = (bf16_t)(pk & 0xffffu); xcT[(2 * tp + 1) * 72 + lane] = (bf16_t)(pk >> 16);
        }
        LDS_WAIT();
        bf16x8 xf[2];
#pragma unroll
        for (int kb = 0; kb < 2; ++kb) xf[kb] = *(const LAS bf16x8*)(xcT + fr * 72 + kb * 32 + fq * 8);
#pragma unroll
        for (int jb = 0; jb < 4; ++jb) {
            f32x4 ar = {0.f, 0.f, 0.f, 0.f}, ai = {0.f, 0.f, 0.f, 0.f};
            ar = __builtin_amdgcn_mfma_f32_16x16x32_bf16(wa[jb][0], xf[0], ar, 0, 0, 0); ar = __builtin_amdgcn_mfma_f32_16x16x32_bf16(wa[jb][1], xf[1], ar, 0, 0, 0);
            ai = __builtin_amdgcn_mfma_f32_16x16x32_bf16(wi[jb][0], xf[0], ai, 0, 0, 0); ai = __builtin_amdgcn_mfma_f32_16x16x32_bf16(wi[jb][1], xf[1], ai, 0, 0, 0);
            *(LAS f32x4*)(Ab + fr * 68 + jb * 16 + 4 * fq) = ar; *(LAS f32x4*)(Gb + fr * 68 + jb * 16 + 4 * fq) = ai;
        }
        LDS_WAIT();
#pragma unroll
        for (int tp = 0; tp < 8; ++tp) {
            const f32x2v za = (f32x2v){Ab[(2 * tp) * 68 + lane], Ab[(2 * tp + 1) * 68 + lane]} + ban, zi = (f32x2v){Gb[(2 * tp) * 68 + lane], Gb[(2 * tp + 1) * 68 + lane]} + bin;
            const f32x2v da = (f32x2v){__builtin_amdgcn_exp2f(za.x), __builtin_amdgcn_exp2f(za.y)} + 1.0f, di = (f32x2v){__builtin_amdgcn_exp2f(zi.x), __builtin_amdgcn_exp2f(zi.y)} + 1.0f;
            const f32x2v r = {__builtin_amdgcn_rcpf(da.x), __builtin_amdgcn_rcpf(da.y)}, ig = {__builtin_amdgcn_rcpf(di.x), __builtin_amdgcn_rcpf(di.y)};
            const f32x2v lal = c8l * r, t = c8x2 * r;
            const f32x2v av = {__builtin_amdgcn_exp2f(lal.x), __builtin_amdgcn_exp2f(lal.y)};
            const f32x2v pl = -t * (1.0f + t * (0.5f + t * (0.16666667f + t * (0.041666668f + t * (0.0083333338f + t * 0.0013888889f)))));
            const f32x2v em = 1.0f - av * av;
            f32x2v mult = {__builtin_amdgcn_sqrtf(t.x > -0.25f ? pl.x : em.x), __builtin_amdgcn_sqrtf(t.y > -0.25f ? pl.y : em.y)};
            if (tp == 0) { if (reset && tb == 0) mult.x = 1.0f; }
            const f32x2v u = mult * ig * xc2[tp];
            const float h0 = av.x * h + u.x, h1 = av.y * h0 + u.y; h = h1;
            if (PASS == 1) ap *= av.x * av.y;
            if (PASS == 2) {
                const f32x2v g = {bf2f(gs[(2 * tp) * 64 + lane]), bf2f(gs[(2 * tp + 1) * 64 + lane])};
                const f32x2v tn = g * (GK1 + GK3 * (g * g));
                const f32x2v dg = (f32x2v){__builtin_amdgcn_exp2f(tn.x), __builtin_amdgcn_exp2f(tn.y)} + 1.0f;
                const f32x2v o = (f32x2v){h0, h1} * g * (f32x2v){__builtin_amdgcn_rcpf(dg.x), __builtin_amdgcn_rcpf(dg.y)};
                const unsigned pk = cvt_pk_bf16(o.x, o.y); bf16_t* mp = MIX + (size_t)(row0 + tb * 16 + 2 * tp) * DM + cgi;
                mp[0] = (bf16_t)(pk & 0xffffu); mp[DM] = (bf16_t)(pk >> 16);
            }
        }
        LDS_WAIT();
        if (tb < 3) {
            *(LAS u32x4*)(xs + lr * 64 + lp * 8) = px0; *(LAS u32x4*)(xs + (lr + 8) * 64 + lp * 8) = px1;
            if (PASS == 2) { *(LAS u32x4*)(gs + lr * 64 + lp * 8) = pg0; *(LAS u32x4*)(gs + (lr + 8) * 64 + lp * 8) = pg1; }
            LDS_WAIT();
        }
    }
    if (PASS == 1) { CA[(size_t)chunk * LW + cgi] = ap; CH[(size_t)chunk * LW + cgi] = h; }
    if (PASS == 2) {
        if (isp && c == 31) { float* o = a.out; o[O_LRUP + (size_t)b * LW + cgi] = h; o[O_CONVP + (size_t)(b * 3 + 0) * LW + cgi] = xm3; o[O_CONVP + (size_t)(b * 3 + 1) * LW + cgi] = xm2; o[O_CONVP + (size_t)(b * 3 + 2) * LW + cgi] = xm1; }
        if (!isp) { float* o = a.out; o[O_LRUS + (size_t)b * LW + cgi] = h; o[O_CONVS + (size_t)(b * 3 + 0) * LW + cgi] = xm3; o[O_CONVS + (size_t)(b * 3 + 1) * LW + cgi] = xm2; o[O_CONVS + (size_t)(b * 3 + 2) * LW + cgi] = xm1; }
    }
}


__device__ __forceinline__ void scan_onepass(const Args& a, int chunk, int nb, LAS unsigned char* wl, int lane) {
    unsigned char* ws = a.ws;
    const bf16_t* PROJ = (const bf16_t*)(ws + WS_PROJ); bf16_t* MIX = (bf16_t*)(ws + WS_MIX);
    unsigned long long* CAR = (unsigned long long*)(ws + WS_CAR);
    const bf16_t* WGT = (const bf16_t*)(ws + WS_WG);
    const int cgi = nb * 64 + lane;
    const bool isp = chunk < 256; const int b = isp ? (chunk >> 5) : (chunk - 256), c = isp ? (chunk & 31) : 0;
    const int row0 = isp ? b * TP + c * 64 : NP + b * TS;
    const bf16_t* xp = PROJ + (size_t)row0 * NINA + cgi;
    const float w0 = a.in[13][0 * LW + cgi], w1 = a.in[13][1 * LW + cgi], w2 = a.in[13][2 * LW + cgi], w3 = a.in[13][3 * LW + cgi], cb = a.in[14][cgi];
    float xm1, xm2, xm3;
    if (isp) { if (c == 0) { xm1 = xm2 = xm3 = 0.f; } else { xm3 = bf2f(*(xp - 3 * NINA)); xm2 = bf2f(*(xp - 2 * NINA)); xm1 = bf2f(*(xp - NINA)); } }
    else { const float* sc = a.in[2] + (size_t)b * 3 * LW + cgi; xm3 = sc[0]; xm2 = sc[LW]; xm1 = sc[2 * LW]; }
    const float lam = a.in[19][cgi]; const float c8 = -8.0f * log1pf(__expf(-lam));
    const float ban = -LOG2E * a.in[16][cgi], bin = -LOG2E * a.in[18][cgi], c8l = c8 * LOG2E, c8x2 = 2.0f * c8;
    constexpr float GK1 = -1.5957691216057308f * LOG2E, GK3 = GK1 * 0.044715f;
    const int fr = lane & 15, fq = lane >> 4;
    LAS bf16_t* xcT = (LAS bf16_t*)wl; LAS float* Ab = (LAS float*)(wl + 2304); LAS float* Gb = (LAS float*)(wl + 6656);
    LAS bf16_t* xs = (LAS bf16_t*)(wl + 11264); LAS bf16_t* gs = (LAS bf16_t*)(wl + 13312);
    const int lr = lane >> 3, lp = lane & 7;
    const bf16_t* tp0 = PROJ + (size_t)(row0 + lr) * NINA + nb * 64 + lp * 8;
    const bool reset = isp && c == 0;
    f32x2v aa[32], uu[32];
    float hl = 0.f, ap = 1.f;
    {
        bf16x8 wa[4][2], wi[4][2];
#pragma unroll
        for (int jb = 0; jb < 4; ++jb)
#pragma unroll
            for (int kb = 0; kb < 2; ++kb) {
                wa[jb][kb] = *(const bf16x8*)(WGT + (size_t)((0 * 12 + nb) * 64 + jb * 16 + fr) * 64 + kb * 32 + fq * 8);
                wi[jb][kb] = *(const bf16x8*)(WGT + (size_t)((1 * 12 + nb) * 64 + jb * 16 + fr) * 64 + kb * 32 + fq * 8); }
        u32x4 px0 = *(const u32x4*)tp0, px1 = *(const u32x4*)(tp0 + (size_t)8 * NINA);
        *(LAS u32x4*)(xs + lr * 64 + lp * 8) = px0; *(LAS u32x4*)(xs + (lr + 8) * 64 + lp * 8) = px1;
        LDS_WAIT();
#pragma unroll
        for (int tb = 0; tb < 4; ++tb) {
            f32x2v xc2[8];
            if (tb < 3) { const bf16_t* tpn = tp0 + (size_t)((tb + 1) * 16) * NINA; px0 = *(const u32x4*)tpn; px1 = *(const u32x4*)(tpn + (size_t)8 * NINA); }
            asm volatile("" ::: "memory");
#pragma unroll
            for (int tp = 0; tp < 8; ++tp) {
                const float x0 = bf2f(xs[(2 * tp) * 64 + lane]), x1 = bf2f(xs[(2 * tp + 1) * 64 + lane]);
                const f32x2v xa = {x0, x1}, xb = {xm1, x0}, xcv = {xm2, xm1}, xd = {xm3, xm2};
                const f32x2v v = cb + w3 * xa + w2 * xb + w1 * xcv + w0 * xd;
                xc2[tp] = v; xm3 = xm1; xm2 = x0; xm1 = x1;
                const unsigned pk = cvt_pk_bf16(v.x, v.y);
                xcT[(2 * tp) * 72 + lane] = (bf16_t)(pk & 0xffffu); xcT[(2 * tp + 1) * 72 + lane] = (bf16_t)(pk >> 16);
            }
            LDS_WAIT();
            bf16x8 xf[2];
#pragma unroll
            for (int kb = 0; kb < 2; ++kb) xf[kb] = *(const LAS bf16x8*)(xcT + fr * 72 + kb * 32 + fq * 8);
#pragma unroll
            for (int jb = 0; jb < 4; ++jb) {
                f32x4 ar = {0.f, 0.f, 0.f, 0.f}, ai = {0.f, 0.f, 0.f, 0.f};
                ar = __builtin_amdgcn_mfma_f32_16x16x32_bf16(wa[jb][0], xf[0], ar, 0, 0, 0); ar = __builtin_amdgcn_mfma_f32_16x16x32_bf16(wa[jb][1], xf[1], ar, 0, 0, 0);
                ai = __builtin_amdgcn_mfma_f32_16x16x32_bf16(wi[jb][0], xf[0], ai, 0, 0, 0); ai = __builtin_amdgcn_mfma_f32_16x16x32_bf16(wi[jb][1], xf[1], ai, 0, 0, 0);
                *(LAS f32x4*)(Ab + fr * 68 + jb * 16 + 4 * fq) = ar; *(LAS f32x4*)(Gb + fr * 68 + jb * 16 + 4 * fq) = ai;
            }
            LDS_WAIT();
#pragma unroll
            for (int tp = 0; tp < 8; ++tp) {
                const f32x2v za = (f32x2v){Ab[(2 * tp) * 68 + lane], Ab[(2 * tp + 1) * 68 + lane]} + ban, zi = (f32x2v){Gb[(2 * tp) * 68 + lane], Gb[(2 * tp + 1) * 68 + lane]} + bin;
                const f32x2v da = (f32x2v){__builtin_amdgcn_exp2f(za.x), __builtin_amdgcn_exp2f(za.y)} + 1.0f, di = (f32x2v){__builtin_amdgcn_exp2f(zi.x), __builtin_amdgcn_exp2f(zi.y)} + 1.0f;
                const f32x2v r = {__builtin_amdgcn_rcpf(da.x), __builtin_amdgcn_rcpf(da.y)}, ig = {__builtin_amdgcn_rcpf(di.x), __builtin_amdgcn_rcpf(di.y)};
                const f32x2v lal = c8l * r, t = c8x2 * r;
                const f32x2v av = {__builtin_amdgcn_exp2f(lal.x), __builtin_amdgcn_exp2f(lal.y)};
                const f32x2v pl = -t * (1.0f + t * (0.5f + t * (0.16666667f + t * (0.041666668f + t * (0.0083333338f + t * 0.0013888889f)))));
                const f32x2v em = 1.0f - av * av;
                f32x2v mult = {__builtin_amdgcn_sqrtf(t.x > -0.25f ? pl.x : em.x), __builtin_amdgcn_sqrtf(t.y > -0.25f ? pl.y : em.y)};
                if (tb == 0 && tp == 0) { if (reset) mult.x = 1.0f; }
                const f32x2v u = mult * ig * xc2[tp];
                aa[tb * 8 + tp] = av; uu[tb * 8 + tp] = u;
                hl = av.x * hl + u.x; hl = av.y * hl + u.y; ap *= av.x * av.y;
            }
            LDS_WAIT();
            if (tb < 3) { *(LAS u32x4*)(xs + lr * 64 + lp * 8) = px0; *(LAS u32x4*)(xs + (lr + 8) * 64 + lp * 8) = px1; LDS_WAIT(); }
        }
    }
    if (isp && c < 31) { const unsigned long long pk = ((unsigned long long)__builtin_bit_cast(unsigned, hl) << 32) | (unsigned long long)__builtin_bit_cast(unsigned, ap);
        __hip_atomic_store(CAR + (size_t)chunk * LW + cgi, pk, __ATOMIC_RELAXED, __HIP_MEMORY_SCOPE_AGENT); }
    u32x4 pg0 = *(const u32x4*)(tp0 + LW), pg1 = *(const u32x4*)(tp0 + (size_t)8 * NINA + LW);
    float h = 0.f;
    if (isp) { unsigned long long* pc = CAR + (size_t)(b * 32) * LW + cgi;
        for (int cq = 0; cq < c; cq += 8) { unsigned long long v[8];
#pragma unroll
            for (int k = 0; k < 8; ++k) { const int cc = (cq + k < c) ? cq + k : c - 1; v[k] = __hip_atomic_load(pc + (size_t)cc * LW, __ATOMIC_RELAXED, __HIP_MEMORY_SCOPE_AGENT); }
#pragma unroll
            for (int k = 0; k < 8; ++k) { const int cc = (cq + k < c) ? cq + k : c - 1; unsigned sp = 0;
                while (v[k] == ~0ull && ++sp < (1u << 20)) { __builtin_amdgcn_s_sleep(2); v[k] = __hip_atomic_load(pc + (size_t)cc * LW, __ATOMIC_RELAXED, __HIP_MEMORY_SCOPE_AGENT); }
                if (cq + k < c) h = __builtin_bit_cast(float, (unsigned)v[k]) * h + __builtin_bit_cast(float, (unsigned)(v[k] >> 32)); } } }
    else h = a.in[3][(size_t)b * LW + cgi];
    *(LAS u32x4*)(gs + lr * 64 + lp * 8) = pg0; *(LAS u32x4*)(gs + (lr + 8) * 64 + lp * 8) = pg1;
    LDS_WAIT();
#pragma unroll
    for (int tb = 0; tb < 4; ++tb) {
        if (tb < 3) { const bf16_t* tpn = tp0 + (size_t)((tb + 1) * 16) * NINA + LW; pg0 = *(const u32x4*)tpn; pg1 = *(const u32x4*)(tpn + (size_t)8 * NINA); }
        asm volatile("" ::: "memory");
#pragma unroll
        for (int tp = 0; tp < 8; ++tp) {
            const f32x2v av = aa[tb * 8 + tp], u = uu[tb * 8 + tp];
            const float h0 = av.x * h + u.x, h1 = av.y * h0 + u.y; h = h1;
            const f32x2v g = {bf2f(gs[(2 * tp) * 64 + lane]), bf2f(gs[(2 * tp + 1) * 64 + lane])};
            const f32x2v tn = g * (GK1 + GK3 * (g * g));
            const f32x2v dg = (f32x2v){__builtin_amdgcn_exp2f(tn.x), __builtin_amdgcn_exp2f(tn.y)} + 1.0f;
            const f32x2v o = (f32x2v){h0, h1} * g * (f32x2v){__builtin_amdgcn_rcpf(dg.x), __builtin_amdgcn_rcpf(dg.y)};
            const unsigned pk = cvt_pk_bf16(o.x, o.y); bf16_t* mp = MIX + (size_t)(row0 + tb * 16 + 2 * tp) * DM + cgi;
            mp[0] = (bf16_t)(pk & 0xffffu); mp[DM] = (bf16_t)(pk >> 16);
        }
        LDS_WAIT();
        if (tb < 3) { *(LAS u32x4*)(gs + lr * 64 + lp * 8) = pg0; *(LAS u32x4*)(gs + (lr + 8) * 64 + lp * 8) = pg1; LDS_WAIT(); }
    }
    if (isp && c == 31) { float* o = a.out; o[O_LRUP + (size_t)b * LW + cgi] = h; o[O_CONVP + (size_t)(b * 3 + 0) * LW + cgi] = xm3; o[O_CONVP + (size_t)(b * 3 + 1) * LW + cgi] = xm2; o[O_CONVP + (size_t)(b * 3 + 2) * LW + cgi] = xm1; }
    if (!isp) { float* o = a.out; o[O_LRUS + (size_t)b * LW + cgi] = h; o[O_CONVS + (size_t)(b * 3 + 0) * LW + cgi] = xm3; o[O_CONVS + (size_t)(b * 3 + 1) * LW + cgi] = xm2; o[O_CONVS + (size_t)(b * 3 + 2) * LW + cgi] = xm1; }
}

__device__ __forceinline__ void attn_bias_tables(const Args& a, LAS unsigned char* lds) {
    LAS float* T = (LAS float*)(lds + 36864);
    for (int e = threadIdx.x; e < 12 * 1568; e += 512) { const int h = e / 1568, rem = e % 1568, sft = rem / 392, jj = rem % 392; int i = jj - 64 + sft; i = i < 0 ? 0 : (i > 319 ? 319 : i); T[e] = a.in[23][(size_t)(512 - i) * 12 + h] * 8.0f; }
}
enum { AT_PB = 0, AT_SB = 1, AT_PM = 2, AT_SM = 3 };
__device__ __forceinline__ int crow(int r, int hi) { return (r & 3) + 8 * (r >> 2) + 4 * hi; }
struct IC0 { static constexpr int value = 0; }; struct IC1 { static constexpr int value = 1; };
__device__ __forceinline__ void attn_item(const Args& a, LAS unsigned char* lds, int mode, int idx, int layer) {
    unsigned char* ws = a.ws;
    const int tid = threadIdx.x, lane = tid & 63, wv = __builtin_amdgcn_readfirstlane(tid >> 6), q = lane & 31, hi = lane >> 5;
    const bf16_t* KVb = (const bf16_t*)(ws + WS_KV); const bf16_t* MKV = (const bf16_t*)(ws + WS_MKV);
    bf16_t* MIX = (bf16_t*)(ws + WS_MIX);
    const bf16_t* Qbuf = (const bf16_t*)(ws + WS_PROJ); const int qpitch = layer == 0 ? NINA : 1024;
    int h, b, row0, nact, j0, j1, c0 = 0, qcol, ocol;
    if (mode == AT_PB) { h = idx % 12; const int grp = idx / 12; b = grp >> 3; const int g8 = grp & 7; c0 = g8 * 4; row0 = b * TP + g8 * 256; nact = 8; j0 = c0 >= 8 ? 0 : 8 - c0; j1 = 11; qcol = h * 64; ocol = h * 64; }
    else if (mode == AT_SB) { h = idx % 12; b = idx / 12; row0 = NP + b * TS; nact = 2; j0 = 0; j1 = 8; qcol = h * 64; ocol = h * 64; }
    else if (mode == AT_PM) { h = idx & 3; const int grp = idx >> 2; b = grp >> 3; row0 = grp * 256; nact = 8; j0 = 0; j1 = 3; qcol = (layer == 0 ? 2 * LW : AW) + h * 64; ocol = AW + h * 64; }
    else { h = idx & 3; b = idx >> 2; row0 = NP + b * TS; nact = 2; j0 = 0; j1 = 3; qcol = (layer == 0 ? 2 * LW : AW) + h * 64; ocol = AW + h * 64; }
    const bool band = mode <= AT_SB, active = wv < nact;
    const int wofs = (mode == AT_PB) ? (wv >> 1) : 0;
    const int qi = ((mode == AT_PB) ? (wv & 1) * 32 : wv * 32) + q;
    LAS float* biasT = (LAS float*)(lds + 36864) + h * 1568;
    __syncthreads();
    bf16x8 qf[4];
    if (active) { const bf16_t* qp = Qbuf + (size_t)(row0 + wv * 32 + q) * qpitch + qcol + hi * 8;
#pragma unroll
        for (int d0 = 0; d0 < 4; ++d0) qf[d0] = *(const bf16x8*)(qp + d0 * 16); }
    const int kvr = lane, pc = wv;
    const int vpos = (kvr & 48) | ((kvr & 3) + 4 * ((kvr >> 3) & 1) + 8 * ((kvr >> 2) & 1));
    const int bi0 = -qi + 4 * hi, bsf = bi0 & 3;
    const LAS float* btab = biasT + bsf * 392 + (bi0 - bsf + 64);
    f32x4 rk0A, rk1A, rv0A, rv1A, rk0B, rk1B, rv0B, rv1B;
    auto tile_f32 = [&](int j) __attribute__((always_inline)) { return (mode == AT_SB && j < 8) || mode == AT_SM; };
    auto load_tile = [&](int j, auto par_) __attribute__((always_inline)) { constexpr int P = decltype(par_)::value;
        const void* kp; const void* vp; bool f32s = false;
        if (mode == AT_PB) { const bf16_t* p = KVb + (size_t)(b * TP + (c0 - 8 + j) * 64 + kvr) * 1536 + h * 64 + pc * 8; kp = p; vp = p + AW; }
        else if (mode == AT_SB) {
            if (j < 8) { const size_t o = ((size_t)(b * 512 + j * 64 + kvr) * 12 + h) * 64 + pc * 8; kp = a.in[4] + o; vp = a.in[5] + o; f32s = true; }
            else { const bf16_t* p = KVb + (size_t)(NP + b * TS + kvr) * 1536 + h * 64 + pc * 8; kp = p; vp = p + AW; } }
        else if (mode == AT_PM) { const bf16_t* p = MKV + (size_t)(b * 256 + j * 64 + kvr) * 1024 + layer * 512 + h * 64 + pc * 8; kp = p; vp = p + 256; }
        else { const size_t o = (((size_t)(layer * BS + b) * 256 + j * 64 + kvr) * 4 + h) * 64 + pc * 8; kp = a.in[6] + o; vp = a.in[7] + o; f32s = true; }
        f32x4& rk0 = P ? rk0B : rk0A; f32x4& rk1 = P ? rk1B : rk1A; f32x4& rv0 = P ? rv0B : rv0A; f32x4& rv1 = P ? rv1B : rv1A;
        rk0 = ((const f32x4*)kp)[0]; rv0 = ((const f32x4*)vp)[0];
        if (f32s) { rk1 = ((const f32x4*)kp)[1]; rv1 = ((const f32x4*)vp)[1]; }
    };
    float m = -1e30f, l = 0.f; f32x16 o0, o1;
#pragma unroll
    for (int r = 0; r < 16; ++r) { o0[r] = 0.f; o1[r] = 0.f; }
    load_tile(j0, IC0{}); if (j0 < j1) load_tile(j0 + 1, IC1{});
    auto step = [&](int j, auto par_) __attribute__((always_inline)) { constexpr int P = decltype(par_)::value;
        const bool rawf32 = tile_f32(j);
        LAS unsigned char* Ks = lds + P * 18432; LAS bf16_t* Vt = (LAS bf16_t*)(Ks + 9216);
        { u32x4 kb, vb;
          const f32x4 rk0 = P ? rk0B : rk0A, rk1 = P ? rk1B : rk1A, rv0 = P ? rv0B : rv0A, rv1 = P ? rv1B : rv1A;
          if (rawf32) { kb = pack8(rk0, rk1); vb = pack8(rv0, rv1); } else { kb = __builtin_bit_cast(u32x4, rk0); vb = __builtin_bit_cast(u32x4, rv0); }
          *(LAS u32x4*)(Ks + kvr * 144 + pc * 16) = kb;
          LAS bf16_t* vd = Vt + (pc * 8) * 72 + vpos;
          vd[0 * 72] = (bf16_t)(vb.x & 0xffffu); vd[1 * 72] = (bf16_t)(vb.x >> 16); vd[2 * 72] = (bf16_t)(vb.y & 0xffffu); vd[3 * 72] = (bf16_t)(vb.y >> 16);
          vd[4 * 72] = (bf16_t)(vb.z & 0xffffu); vd[5 * 72] = (bf16_t)(vb.z >> 16); vd[6 * 72] = (bf16_t)(vb.w & 0xffffu); vd[7 * 72] = (bf16_t)(vb.w >> 16); }
        asm volatile("s_waitcnt lgkmcnt(0)\n\ts_barrier" ::: "memory");
        if (j + 2 <= j1) load_tile(j + 2, par_);
        const int jrel = j - wofs;
        if (active && jrel >= 0 && (!band || jrel <= 8)) {
            f32x16 p0, p1;
#pragma unroll
            for (int r = 0; r < 16; ++r) { p0[r] = 0.f; p1[r] = 0.f; }
            const LAS unsigned char* kp = Ks + q * 144 + hi * 16;
#pragma unroll
            for (int d0 = 0; d0 < 4; ++d0) { const bf16x8 k0 = *(const LAS bf16x8*)(kp + d0 * 32), k1 = *(const LAS bf16x8*)(kp + 32 * 144 + d0 * 32);
                p0 = __builtin_amdgcn_mfma_f32_32x32x16_bf16(k0, qf[d0], p0, 0, 0, 0); p1 = __builtin_amdgcn_mfma_f32_32x32x16_bf16(k1, qf[d0], p1, 0, 0, 0); }
            const float C = 0.125f * LOG2E;
            if (band) {
                if (jrel <= 3) { const float bc = biasT[0];
                    p0 += bc; p1 += bc; }
                else { const LAS float* bt = btab + (jrel - 4) * 64;
#pragma unroll
                    for (int g = 0; g < 4; ++g) { const f32x4 b0 = *(const LAS f32x4*)(bt + 8 * g), b1 = *(const LAS f32x4*)(bt + 8 * g + 32);
#pragma unroll
                        for (int c = 0; c < 4; ++c) { p0[4 * g + c] += b0[c]; p1[4 * g + c] += b1[c]; } } }
            }
            float mx = fmaxf(p0[0], p1[0]);
#pragma unroll
            for (int r = 1; r < 16; ++r) mx = fmaxf(mx, fmaxf(p0[r], p1[r]));
            mx = fmaxf(mx, __shfl_xor(mx, 32));
            if (__any(mx > m + 44.0f)) {
                const float mn = fmaxf(m, mx), sc = __builtin_amdgcn_exp2f((m - mn) * C); m = mn; l *= sc;
#pragma unroll
                for (int r = 0; r < 16; ++r) { o0[r] *= sc; o1[r] *= sc; }
            }
            const float nmc = -m * C;
            p0 = p0 * C + nmc; p1 = p1 * C + nmc;
#pragma unroll
            for (int r = 0; r < 16; ++r) { p0[r] = __builtin_amdgcn_exp2f(p0[r]); p1[r] = __builtin_amdgcn_exp2f(p1[r]); }
            { const f32x16 sv = p0 + p1;
              const f32x4 s4 = (f32x4){sv[0], sv[1], sv[2], sv[3]} + (f32x4){sv[4], sv[5], sv[6], sv[7]} + (f32x4){sv[8], sv[9], sv[10], sv[11]} + (f32x4){sv[12], sv[13], sv[14], sv[15]};
              l += (s4[0] + s4[1]) + (s4[2] + s4[3]); }
            bf16x8 pw[4];
            { u32x4 t; t.x = cvt_pk_bf16(p0[0], p0[1]); t.y = cvt_pk_bf16(p0[2], p0[3]); t.z = cvt_pk_bf16(p0[4], p0[5]); t.w = cvt_pk_bf16(p0[6], p0[7]); pw[0] = __builtin_bit_cast(bf16x8, t);
              t.x = cvt_pk_bf16(p0[8], p0[9]); t.y = cvt_pk_bf16(p0[10], p0[11]); t.z = cvt_pk_bf16(p0[12], p0[13]); t.w = cvt_pk_bf16(p0[14], p0[15]); pw[1] = __builtin_bit_cast(bf16x8, t);
              t.x = cvt_pk_bf16(p1[0], p1[1]); t.y = cvt_pk_bf16(p1[2], p1[3]); t.z = cvt_pk_bf16(p1[4], p1[5]); t.w = cvt_pk_bf16(p1[6], p1[7]); pw[2] = __builtin_bit_cast(bf16x8, t);
              t.x = cvt_pk_bf16(p1[8], p1[9]); t.y = cvt_pk_bf16(p1[10], p1[11]); t.z = cvt_pk_bf16(p1[12], p1[13]); t.w = cvt_pk_bf16(p1[14], p1[15]); pw[3] = __builtin_bit_cast(bf16x8, t); }
#pragma unroll
            for (int k = 0; k < 4; ++k) {
                const LAS bf16_t* v0p = Vt + q * 72 + k * 16 + 8 * hi;
                const bf16x8 vf0 = *(const LAS bf16x8*)v0p, vf1 = *(const LAS bf16x8*)(v0p + 32 * 72);
                o0 = __builtin_amdgcn_mfma_f32_32x32x16_bf16(vf0, pw[k], o0, 0, 0, 0); o1 = __builtin_amdgcn_mfma_f32_32x32x16_bf16(vf1, pw[k], o1, 0, 0, 0);
            }
        }
    };
    for (int j = j0; j <= j1; j += 2) { step(j, IC0{}); if (j < j1) step(j + 1, IC1{}); }
    if (active) {
        l += __shfl_xor(l, 32); const float inv = 1.0f / l;
        bf16_t* op = MIX + (size_t)(row0 + wv * 32 + q) * DM + ocol + 4 * hi;
#pragma unroll
        for (int g = 0; g < 4; ++g) {
            u32x2 w0, w1; w0.x = cvt_pk_bf16(o0[4 * g] * inv, o0[4 * g + 1] * inv); w0.y = cvt_pk_bf16(o0[4 * g + 2] * inv, o0[4 * g + 3] * inv);
            w1.x = cvt_pk_bf16(o1[4 * g] * inv, o1[4 * g + 1] * inv); w1.y = cvt_pk_bf16(o1[4 * g + 2] * inv, o1[4 * g + 3] * inv);
            *(u32x2*)(op + 8 * g) = w0; *(u32x2*)(op + 32 + 8 * g) = w1; }
    }
}

#define XB_TMO      128
#define XB_XCNT(j)  (256  + 64 * (j))
#define XB_XSUB(j)  (1280 + 64 * (j))
#define XB_XGEN(j)  (2304 + 64 * (j))
#define XB_TOP      3328
#define XB_TOPGEN   3392
#define XCD_BAR_WORDS 3456
#define XB_SPIN_CAP (1u << 18)

__device__ __forceinline__ unsigned xb_ld(unsigned* p)              { return __hip_atomic_load(p, __ATOMIC_RELAXED, __HIP_MEMORY_SCOPE_AGENT); }
__device__ __forceinline__ unsigned xb_add(unsigned* p, unsigned v) { return __hip_atomic_fetch_add(p, v, __ATOMIC_RELAXED, __HIP_MEMORY_SCOPE_AGENT); }
__device__ __forceinline__ unsigned xb_xcc_id() { return (unsigned)__builtin_amdgcn_s_getreg((3 << 11) | 20) & 0xFu; }
#define XB_SPIN(cond, bar) do { unsigned _sp = 0; while (cond) { __builtin_amdgcn_s_sleep(1); \
    if ((++_sp & 255u) == 0u) { if (xb_ld(&(bar)[XB_TMO])) break; if (_sp > XB_SPIN_CAP) { atomicAdd(&(bar)[XB_TMO], 1u); break; } } } } while (0)

struct XcdBarrier {
    unsigned* bar; unsigned x;
    volatile LAS unsigned* st;
};

__device__ __forceinline__ XcdBarrier xcd_barrier_post(unsigned* bar, volatile LAS unsigned* st) {
    XcdBarrier b; b.bar = bar; b.x = xb_xcc_id(); b.st = st;
    if (threadIdx.x == 0) (void)xb_add(&bar[XB_XCNT(b.x)], 1u);
    return b;
}
__device__ __forceinline__ void xcd_barrier_complete(unsigned* bar, unsigned x, unsigned& nloc, unsigned& nx) {
    const unsigned G = gridDim.x * gridDim.y * gridDim.z;
    unsigned sum, cnt, mine, sp = 0u;
    for (;;) {
        sum = 0u; cnt = 0u; mine = 0u;
#pragma unroll
        for (unsigned j = 0; j < 16; ++j) { const unsigned c = xb_ld(&bar[XB_XCNT(j)]); sum += c; cnt += (c > 0u) ? 1u : 0u; mine = (j == x) ? c : mine; }
        if (sum == G) break;
        __builtin_amdgcn_s_sleep(1);
        if ((++sp & 255u) == 0u) { if (xb_ld(&bar[XB_TMO])) break; if (sp > XB_SPIN_CAP) { atomicAdd(&bar[XB_TMO], 1u); break; } }
    }
    nloc = mine > 0u ? mine : 1u; nx = cnt > 0u ? cnt : 1u;
}

__device__ __forceinline__ void xcd_barrier(const XcdBarrier& b) {
    asm volatile("s_waitcnt vmcnt(0)" ::: "memory");
    __syncthreads();
    if (threadIdx.x == 0) {
        unsigned* bar = b.bar;
        __builtin_amdgcn_s_waitcnt(0);
        unsigned nloc = b.st[0], nx = b.st[1];
        if (nloc == 0u) { xcd_barrier_complete(bar, b.x, nloc, nx); b.st[0] = nloc; b.st[1] = nx; }
        const unsigned old = xb_add(&bar[XB_XSUB(b.x)], 1u);
        const unsigned gen = old / nloc;
        if (old + 1u == (gen + 1u) * nloc) {
            __builtin_amdgcn_fence(__ATOMIC_RELEASE, "agent");
            asm volatile("s_waitcnt vmcnt(0)" ::: "memory");
            const unsigned og = xb_add(&bar[XB_TOP], 1u);
            const unsigned tg = og / nx;
            if (og + 1u == (tg + 1u) * nx) xb_add(&bar[XB_TOPGEN], 1u);
            else XB_SPIN(xb_ld(&bar[XB_TOPGEN]) == tg, bar);
            __builtin_amdgcn_fence(__ATOMIC_ACQUIRE, "agent");
            xb_add(&bar[XB_XGEN(b.x)], 1u);
            asm volatile("s_waitcnt vmcnt(0)" ::: "memory");
        } else {
            XB_SPIN(xb_ld(&bar[XB_XGEN(b.x)]) == gen, bar);
            __builtin_amdgcn_fence(__ATOMIC_ACQUIRE, "agent");
            asm volatile("s_waitcnt vmcnt(0)" ::: "memory");
        }
    }
    __syncthreads();
}

constexpr int NPHASE = 16;
__global__ void __launch_bounds__(512, 2) yoco_fwd(Args a) {
    extern __shared__ __attribute__((aligned(16))) unsigned char lds_raw[];
    LAS unsigned char* lds = (LAS unsigned char*)lds_raw;
    cg::grid_group grid = cg::this_grid();
    const int tid = threadIdx.x, lane = tid & 63, wave = __builtin_amdgcn_readfirstlane(tid >> 6);
    const int G = gridDim.x, gw = blockIdx.x * 8 + wave, NGW = G * 8;
    unsigned char* ws = a.ws; float* out = a.out;
    bf16_t* WINA = (bf16_t*)(ws + WS_WINA); bf16_t* WKVB = (bf16_t*)(ws + WS_WKVB); bf16_t* WMEM = (bf16_t*)(ws + WS_WMEM); bf16_t* WOUT = (bf16_t*)(ws + WS_WOUT);
    bf16_t* WGU = (bf16_t*)(ws + WS_WGU); bf16_t* WDN = (bf16_t*)(ws + WS_WDN); bf16_t* WGT = (bf16_t*)(ws + WS_WG);
    bf16_t* MN = (bf16_t*)(ws + WS_MN); bf16_t* MKV = (bf16_t*)(ws + WS_MKV); bf16_t* XN = (bf16_t*)(ws + WS_XN); bf16_t* KVb = (bf16_t*)(ws + WS_KV);
    bf16_t* HB = (bf16_t*)(ws + WS_H); bf16_t* PROJ = (bf16_t*)(ws + WS_PROJ); bf16_t* MIX = (bf16_t*)(ws + WS_MIX);
    float* X = out + O_Y; float* SS = (float*)(ws + WS_SS); bf16_t* PART = (bf16_t*)(ws + WS_PART);
    const int lo = a.ph_lo, hi = a.ph_hi;
    volatile LAS unsigned* MISC = (volatile LAS unsigned*)(lds + 131072 + 512);
    if (tid < 2) MISC[tid] = 0u;
    __syncthreads();
    XcdBarrier bar; bar.bar = (unsigned*)(ws + WS_BAR); bar.x = 0; bar.st = MISC;
    if (hi - lo > 1) bar = xcd_barrier_post((unsigned*)(ws + WS_BAR), MISC);
    if ((a.flags >> 30) & 1) grid.sync();
#if DUP_MASK
    const float esc = (a.flags & 1) ? 0.f : 1.f;
#else
    constexpr float esc = 1.f;
#endif
#define IN(k) (lo <= (k) && (k) < hi)
#define SEAM(k) do { if (IN(k) && IN((k) + 1)) { xcd_barrier(bar); } } while (0)

    if (IN(0)) {
        LAS float* scr = (LAS float*)(lds + wave * 16384);
        for (int it = gw; it < W_EARLY; it += NGW) weight_item(a, it, scr, lane);
        for (int e = blockIdx.x * 512 + tid; e < 2 * 12 * 4096; e += G * 512) {
            const int gsel = e / (12 * 4096), rem = e % (12 * 4096), n = rem >> 12, j = (rem >> 6) & 63, i = rem & 63;
            WGT[e] = (bf16_t)f2bf(-LOG2E * a.in[gsel ? 17 : 15][(size_t)n * 4096 + i * 64 + j]);
        }
        for (int e = blockIdx.x * 512 + tid; e < 3 * MT; e += G * 512) SS[e] = 0.f;
        { unsigned long long* CAR = (unsigned long long*)(ws + WS_CAR); for (int e = blockIdx.x * 512 + tid; e < 256 * LW; e += G * 512) CAR[e] = ~0ull; }
        for (int mrow = gw * 2; mrow < MT + NMEMR; mrow += NGW * 2) {
            const float* src; bf16_t* dst; float* ssp = SS + 3 * MT + mrow;
            if (mrow < NP) { src = a.in[0] + (size_t)mrow * DM; dst = XN + (size_t)mrow * DM; }
            else if (mrow < MT) { src = a.in[1] + (size_t)(mrow - NP) * DM; dst = XN + (size_t)mrow * DM; }
            else { src = a.in[8] + (size_t)(mrow - MT) * DM; dst = MN + (size_t)(mrow - MT) * DM; ssp = nullptr; }
            norm_row2_bf16(src, dst, ssp, lane);
        }
    }
    SEAM(0);
    if (IN(1)) {
        { EpiMemKV E{MKV, out}; run_gemm(lds, MN, WMEM, NMEMR, 1024, 1024, E); }
        { EpiBf16Plain E{PROJ, NINA, nullptr}; run_gemm_ss(lds, XN, WINA, MT, NINA, 1024, E, SS + 3 * MT); }
        {
            const int c0 = G > 64 ? 32 : 0, nw = (G - c0) * 8; LAS float* scr = (LAS float*)(lds + wave * 16384);
            if ((int)blockIdx.x >= c0) for (int q = ((int)blockIdx.x - c0) * 8 + wave; q < W_P1; q += nw) weight_item(a, witem_p1(q), scr, lane);
        }
    }
    SEAM(1);
    if (IN(2)) {
        for (int it = gw; it < 288 * 12; it += NGW) scan_onepass(a, it / 12, it % 12, lds + wave * 16384, lane);
        __syncthreads();
        for (int it = blockIdx.x; it < 256; it += G) attn_item(a, lds, AT_PM, it, 0);
        { const int b0 = G >= 256 ? 176 : 0; if ((int)blockIdx.x >= b0) for (int it = (int)blockIdx.x - b0; it < 128; it += G - b0) attn_item(a, lds, AT_SM, it, 0); }
    }
    SEAM(2);
    if (IN(4)) { EpiResid E{nullptr, XN, nullptr, XN, SS, PART, esc}; run_gemm_resid(lds, MIX, WOUT, 1024, E); }
    SEAM(4);
    if (IN(5)) { for (int sr = gw; sr < NS; sr += NGW) reduce_row(nullptr, XN + (size_t)(NP + sr) * DM, PART, sr, XN + (size_t)(NP + sr) * DM, SS + NP + sr, lane); }
    SEAM(5);
    if (IN(6)) { EpiSwiGLU E{HB, nullptr}; run_gemm_ss(lds, XN, WGU, MT, 2 * DFF, 1024, E, SS);
        {
            const int c0 = G > 96 ? 48 : 0, nw = (G - c0) * 8; LAS float* scr = (LAS float*)(lds + wave * 16384);
            if ((int)blockIdx.x >= c0) for (int q = ((int)blockIdx.x - c0) * 8 + wave; q < W_P6; q += nw) weight_item(a, witem_p6(q), scr, lane);
        } }
    SEAM(6);
    if (IN(7)) { EpiResid E{nullptr, XN, nullptr, XN, SS + MT, PART, esc}; run_gemm_resid(lds, HB, WDN, DFF, E); }
    SEAM(7);
    if (IN(8)) { for (int sr = gw; sr < NS; sr += NGW) reduce_row(nullptr, XN + (size_t)(NP + sr) * DM, PART, sr, XN + (size_t)(NP + sr) * DM, SS + MT + NP + sr, lane); }
    SEAM(8);
    if (IN(9)) { EpiKVQ E{KVb, PROJ, out, nullptr}; run_gemm_ss(lds, XN, WKVB, MT, NKVQ, 1024, E, SS + MT); }
    SEAM(9);
    if (IN(10)) {
        __syncthreads(); attn_bias_tables(a, lds);
        for (int it = blockIdx.x; it < 768 + 256 + 384 + 128; it += G) {
            if (it < 768) attn_item(a, lds, AT_PB, it, 1);
            else if (it < 1024) attn_item(a, lds, AT_PM, it - 768, 1);
            else if (it < 1408) attn_item(a, lds, AT_SB, it - 1024, 1);
            else attn_item(a, lds, AT_SM, it - 1408, 1);
        }
    }
    SEAM(10);
    if (IN(11)) { EpiResid E{nullptr, XN, nullptr, XN, SS + 2 * MT, PART, esc}; run_gemm_resid(lds, MIX, WOUT + (size_t)1024 * 1024, 1024, E); }
    SEAM(11);
    if (IN(12)) { for (int sr = gw; sr < NS; sr += NGW) reduce_row(nullptr, XN + (size_t)(NP + sr) * DM, PART, sr, XN + (size_t)(NP + sr) * DM, SS + 2 * MT + NP + sr, lane); }
    SEAM(12);
    if (IN(13)) { EpiSwiGLU E{HB, nullptr}; run_gemm_ss(lds, XN, WGU + (size_t)2 * DFF * 1024, MT, 2 * DFF, 1024, E, SS + 2 * MT); }
    SEAM(13);
    if (IN(14)) { EpiResid E{nullptr, XN, nullptr, XN, nullptr, PART, esc}; run_gemm_resid(lds, HB, WDN + (size_t)1024 * DFF, DFF, E); }
    SEAM(14);
    if (IN(15)) {
        for (int mrow = gw * 2; mrow < NP; mrow += NGW * 2) norm_row2_final_h(XN + (size_t)mrow * DM, X + (size_t)mrow * DM, a.in[11], lane);
        for (int mrow = NP + gw; mrow < MT; mrow += NGW) {
            { f32x4 v[4]; float* xr = X + (size_t)mrow * DM; const float rstd = rstd_of(reduce_row_regs(nullptr, XN + (size_t)mrow * DM, PART, mrow - NP, lane, v));
#pragma unroll
                for (int j = 0; j < 4; ++j) ((f32x4*)xr)[lane + 64 * j] = v[j] * rstd * ((const f32x4*)a.in[11])[lane + 64 * j]; }
        }
    }
#undef IN
#undef SEAM
}

extern "C" void kernel_launch(void* const* d_in, const int* in_sizes, int n_in, void* d_out, int out_size, void* d_ws, size_t ws_size, hipStream_t stream) {
    static int grid = 0;
    if (grid == 0) {
        if (n_in != 29 || (size_t)out_size != O_END || ws_size < WS_END) { fprintf(stderr, "kernel_launch: unexpected shapes: n_in %d out %d ws %zu\n", n_in, out_size, ws_size); grid = -1; return; }
        int dev = 0, cus = 0, per_cu = 0;
        hipGetDevice(&dev); hipDeviceGetAttribute(&cus, hipDeviceAttributeMultiprocessorCount, dev);
        if (hipFuncSetAttribute((const void*)yoco_fwd, hipFuncAttributeMaxDynamicSharedMemorySize, LDS_BYTES) != hipSuccess) { fprintf(stderr, "kernel_launch: hipFuncSetAttribute failed\n"); grid = -1; return; }
        if (hipOccupancyMaxActiveBlocksPerMultiprocessor(&per_cu, (const void*)yoco_fwd, 512, LDS_BYTES) != hipSuccess || per_cu < 1) { fprintf(stderr, "kernel_launch: occupancy query says %d\n", per_cu); per_cu = 1; }
        (void)hipGetLastError();
        grid = cus;
        fprintf(stderr, "kernel_launch: grid %d (per_cu %d)\n", grid, per_cu);
    }
    if (grid < 0) return;
    Args a{};
    for (int i = 0; i < 29; ++i) a.in[i] = (const float*)d_in[i];
    a.out = (float*)d_out; a.ws = (unsigned char*)d_ws;
#if MK_N_LAUNCHES == 1
    if (hipMemsetAsync((char*)d_ws + WS_BAR, 0, 16384, stream) != hipSuccess) { fprintf(stderr, "kernel_launch: memset of barrier words failed\n"); return; }
    a.ph_lo = 0; a.ph_hi = NPHASE;
    void* args[] = {&a};
    hipError_t e = hipLaunchCooperativeKernel((const void*)yoco_fwd, dim3(grid), dim3(512), args, LDS_BYTES, stream);
    if (e != hipSuccess) fprintf(stderr, "cooperative launch failed: %s (grid %d)\n", hipGetErrorString(e), grid);
#else
    for (int p = 0; p < NPHASE; ++p) for (int rep = ((DUP_MASK >> p) & 1) ? 0 : 1; rep < 2; ++rep) { a.ph_lo = p; a.ph_hi = p + 1; a.flags = rep == 0 ? 1 : 0; hipLaunchKernelGGL(yoco_fwd, dim3(grid), dim3(512), LDS_BYTES, stream, a); }
#endif
}
```
